# Optimizing an MI355X kernel written in HIP

```python
import jax
import jax.numpy as jnp
from jax import lax
import numpy as np

D_MODEL = 1024
BATCH = 32
SEQ = 2048
DEPTH = 1

CHUNK = 64
HEAD_DIM = 64
N_HEADS_A = 8
LEFT_CHUNKS_A = 8
MAX_REL = 128
N_HEADS_B = 8
N_KV_B = 2
WINDOW_B = 128
LEFT_CHUNKS_B = WINDOW_B // CHUNK
ROT_DIM = HEAD_DIM // 4
ROPE_THETA = 500000.0
D_FF = 2816
EPS = 1e-6
NEG_INF = -1e30

W_A = N_HEADS_A * HEAD_DIM
W_QB = N_HEADS_B * HEAD_DIM
W_KVB = N_KV_B * HEAD_DIM
D_IN = 3 * W_A + W_QB + 2 * W_KVB
D_MIX = W_A + W_QB

kernel_name = "hybrid_chunk_stream_encoder_layer"


def rms_norm(x, g):
    xf = x.astype(jnp.float32)
    y = xf * lax.rsqrt(jnp.mean(xf * xf, axis=-1, keepdims=True) + EPS)
    return (y * g.astype(jnp.float32)).astype(x.dtype)


def swiglu(x, w_gate, w_up, w_down):
    return (jax.nn.silu(x @ w_gate) * (x @ w_up)) @ w_down


def partial_rope(x, pos):
    half = ROT_DIM // 2
    inv_freq = jnp.power(jnp.float32(ROPE_THETA), -jnp.arange(half, dtype=jnp.float32) * (2.0 / ROT_DIM))
    ang = pos.astype(jnp.float32)[..., None] * inv_freq
    cos = jnp.cos(ang)[:, :, None, :]
    sin = jnp.sin(ang)[:, :, None, :]
    xr = x[..., :ROT_DIM].astype(jnp.float32)
    x1, x2 = xr[..., :half], xr[..., half:]
    rot = jnp.concatenate([x1 * cos - x2 * sin, x2 * cos + x1 * sin], axis=-1).astype(x.dtype)
    return jnp.concatenate([rot, x[..., ROT_DIM:]], axis=-1)


def rel_position_bias(table):
    band = (LEFT_CHUNKS_A + 1) * CHUNK
    i = jnp.arange(CHUNK)[:, None]
    j = jnp.arange(band)[None, :]
    dist = LEFT_CHUNKS_A * CHUNK + i - j
    idx = jnp.clip(dist, -MAX_REL, MAX_REL) + MAX_REL
    return table[:, idx]


def band_attention(q, k, v, left_chunks, bias, sinks):
    b, s, hkv, g, dh = q.shape
    n_chunks = s // CHUNK
    band = (left_chunks + 1) * CHUNK
    pad = left_chunks * CHUNK
    kp = jnp.pad(k, ((0, 0), (pad, 0), (0, 0), (0, 0)))
    vp = jnp.pad(v, ((0, 0), (pad, 0), (0, 0), (0, 0)))
    scale = dh ** -0.5
    key_off = jnp.arange(band) - pad

    def one_chunk(c):
        start = c * CHUNK
        qc = lax.dynamic_slice_in_dim(q, start, CHUNK, axis=1).astype(jnp.float32)
        kc = lax.dynamic_slice_in_dim(kp, start, band, axis=1).astype(jnp.float32)
        vc = lax.dynamic_slice_in_dim(vp, start, band, axis=1).astype(jnp.float32)
        logits = jnp.einsum('bqhgd,bkhd->bhgqk', qc, kc) * scale
        if bias is not None:
            logits = logits + bias.astype(jnp.float32)
        valid = (start + key_off) >= 0
        logits = jnp.where(valid, logits, NEG_INF)
        if sinks is None:
            p = jax.nn.softmax(logits, axis=-1)
        else:
            sk = sinks.astype(jnp.float32)[None, :, :, None, None]
            m = jnp.maximum(jnp.max(logits, axis=-1, keepdims=True), sk)
            e = jnp.exp(logits - m)
            p = e / (jnp.sum(e, axis=-1, keepdims=True) + jnp.exp(sk - m))
        out = jnp.einsum('bhgqk,bkhd->bqhgd', p, vc)
        return out.astype(q.dtype)

    outs = lax.map(one_chunk, jnp.arange(n_chunks))
    return jnp.moveaxis(outs, 0, 1).reshape(b, s, hkv * g, dh)


def hybrid_mixer(u, positions, w_in, rel_table_a, sinks_b, w_out):
    b, s, _ = u.shape
    proj = u @ w_in
    qa, ka, va, qb, kb, vb = jnp.split(
        proj, [W_A, 2 * W_A, 3 * W_A, 3 * W_A + W_QB, 3 * W_A + W_QB + W_KVB], axis=-1)
    qa = qa.reshape(b, s, N_HEADS_A, 1, HEAD_DIM)
    ka = ka.reshape(b, s, N_HEADS_A, HEAD_DIM)
    va = va.reshape(b, s, N_HEADS_A, HEAD_DIM)
    bias_a = rel_position_bias(rel_table_a)[:, None]
    oa = band_attention(qa, ka, va, LEFT_CHUNKS_A, bias_a, None).reshape(b, s, W_A)
    qb = partial_rope(qb.reshape(b, s, N_HEADS_B, HEAD_DIM), positions)
    qb = qb.reshape(b, s, N_KV_B, N_HEADS_B // N_KV_B, HEAD_DIM)
    kb = partial_rope(kb.reshape(b, s, N_KV_B, HEAD_DIM), positions)
    vb = vb.reshape(b, s, N_KV_B, HEAD_DIM)
    sk = sinks_b.reshape(N_KV_B, N_HEADS_B // N_KV_B)
    ob = band_attention(qb, kb, vb, LEFT_CHUNKS_B, None, sk).reshape(b, s, W_QB)
    return jnp.concatenate([oa, ob], axis=-1) @ w_out


def setup_inputs(seed: int = 0) -> dict:
    key = jax.random.key(seed)
    ks = jax.random.split(key, 20)
    f32 = jnp.float32

    def nrm(k, shape, scale):
        return jax.random.normal(k, shape, f32) * scale

    def gain(k):
        return 1.0 + 0.05 * jax.random.normal(k, (DEPTH, D_MODEL), f32)

    x = jax.random.normal(ks[0], (BATCH, SEQ, D_MODEL), f32)
    offset = jax.random.randint(ks[1], (BATCH, 1), 0, 256) * CHUNK
    positions = (offset + jnp.arange(SEQ, dtype=jnp.int32)[None, :]).astype(jnp.int32)
    return {
        "x": x,
        "positions": positions,
        "ffn1_pre_g": gain(ks[2]),
        "ffn1_w_gate": nrm(ks[3], (DEPTH, D_MODEL, D_FF), D_MODEL ** -0.5),
        "ffn1_w_up": nrm(ks[4], (DEPTH, D_MODEL, D_FF), D_MODEL ** -0.5),
        "ffn1_w_down": nrm(ks[5], (DEPTH, D_FF, D_MODEL), D_FF ** -0.5),
        "ffn1_post_g": gain(ks[6]),
        "mix_pre_g": gain(ks[7]),
        "w_in": nrm(ks[8], (DEPTH, D_MODEL, D_IN), D_MODEL ** -0.5),
        "rel_bias_a": nrm(ks[9], (DEPTH, N_HEADS_A, 2 * MAX_REL + 1), 0.1),
        "sinks_b": nrm(ks[10], (DEPTH, N_HEADS_B), 0.5),
        "w_out": nrm(ks[11], (DEPTH, D_MIX, D_MODEL), D_MIX ** -0.5),
        "mix_post_g": gain(ks[12]),
        "ffn2_pre_g": gain(ks[13]),
        "ffn2_w_gate": nrm(ks[14], (DEPTH, D_MODEL, D_FF), D_MODEL ** -0.5),
        "ffn2_w_up": nrm(ks[15], (DEPTH, D_MODEL, D_FF), D_MODEL ** -0.5),
        "ffn2_w_down": nrm(ks[16], (DEPTH, D_FF, D_MODEL), D_FF ** -0.5),
        "ffn2_post_g": gain(ks[17]),
        "final_g": gain(ks[18]),
    }


def reference(x, positions, ffn1_pre_g, ffn1_w_gate, ffn1_w_up, ffn1_w_down, ffn1_post_g,
              mix_pre_g, w_in, rel_bias_a, sinks_b, w_out, mix_post_g,
              ffn2_pre_g, ffn2_w_gate, ffn2_w_up, ffn2_w_down, ffn2_post_g, final_g):
    h = x
    for l in range(DEPTH):
        f = swiglu(rms_norm(h, ffn1_pre_g[l]), ffn1_w_gate[l], ffn1_w_up[l], ffn1_w_down[l])
        h = h + 0.5 * rms_norm(f, ffn1_post_g[l])
        m = hybrid_mixer(rms_norm(h, mix_pre_g[l]), positions, w_in[l], rel_bias_a[l],
                         sinks_b[l], w_out[l])
        h = h + rms_norm(m, mix_post_g[l])
        f = swiglu(rms_norm(h, ffn2_pre_g[l]), ffn2_w_gate[l], ffn2_w_up[l], ffn2_w_down[l])
        h = h + 0.5 * rms_norm(f, ffn2_post_g[l])
        h = rms_norm(h, final_g[l])
    return h
```

```cpp
#include <hip/hip_runtime.h>
#include <hip/hip_cooperative_groups.h>
#include <cstdio>
#include <cstdint>
#include <cmath>
namespace cg = cooperative_groups;
namespace pg8 {
#define PG8_LAS __attribute__((address_space(3)))
typedef unsigned short bf16_t;
typedef short bf16x8 __attribute__((ext_vector_type(8)));
typedef float f32x4 __attribute__((ext_vector_type(4)));
typedef unsigned u32x4 __attribute__((ext_vector_type(4)));
constexpr int BM = 256, BK = 64, HALF = 128, HTB = HALF * BK * 2  , STAGE_BYTES = 8 * HTB, NXCD = 8, WGM = 8;

__host__ __device__ __forceinline__ int lds_byte(int r, int c) { const int st = (r >> 4) * 2 + (c >> 5), rr = r & 15, cc = c & 31, ob = rr * 64 + cc * 2; return st * 1024 + (ob ^ (((ob >> 9) & 1) << 5)); }
__host__ __device__ __forceinline__ void stage_rc(int b, int& R, int& C) { const int st = b / 1024, sb = b % 1024, swz = sb ^ (((sb >> 9) & 1) << 5); R = (st >> 1) * 16 + swz / 64; C = (st & 1) * 32 + (swz % 64) / 2; }
__host__ __device__ __forceinline__ int perm32(int rho) { const int n = rho >> 4, i = rho & 15; return 8 * (i >> 2) + 4 * n + (i & 3); }

struct Unit { int pm, pn; };
struct Gemm { const bf16_t* A; const bf16_t* Bt; int M, N, K; };

struct StaticOrder {
    int nM, nN, nwg, G, c;
    __host__ __device__ void init(int M, int N, int G_, int c_) { nM = M / BM; nN = N / BM; nwg = nM * nN; G = G_; c = c_; }
    __host__ __device__ bool next(int i, Unit& u) const {
        const long L = (long)i * G + c; if (L >= nwg) return false;
        int wgid = (int)L; { const int q = nwg / NXCD, r = nwg % NXCD, xcd = wgid % NXCD, off = wgid / NXCD; wgid = (xcd < r ? xcd * (q + 1) : r * (q + 1) + (xcd - r) * q) + off; }
        const int nig = WGM * nN, gid = wgid / nig, fm = gid * WGM, gsz = (nM - fm) < WGM ? (nM - fm) : WGM;
        u.pm = fm + ((wgid % nig) % gsz); u.pn = (wgid % nig) / gsz; return true;
    }
    __device__ __forceinline__ void a_ready(const Unit&) const {}
    __device__ __forceinline__ void done(const Unit&) const {}
};

__device__ __forceinline__ unsigned cvt_pk_bf16(float lo, float hi) { unsigned r; asm volatile("v_cvt_pk_bf16_f32 %0, %1, %2" : "=v"(r) : "v"(lo), "v"(hi)); return r; }
__device__ __forceinline__ float silu_mul(float g, float u) { return g * u * __builtin_amdgcn_rcpf(1.0f + __builtin_amdgcn_exp2f(-1.4426950408889634f * g)); }
struct EpiSwiglu {
    static constexpr bool PERM = true, AFTER_DRAIN = false;
    bf16_t* O; int ldc;
    __device__ __forceinline__ void operator()(const f32x4 (&acc)[2][2][4][2], const Unit& u, int wr, int wc, int fr, int fq) const {
        const int row0 = u.pm * BM + wr * 64 + fr; const int col0 = u.pn * HALF + wc * 32 + 8 * fq;
#pragma unroll
        for (int ai = 0; ai < 2; ++ai)
#pragma unroll
            for (int m = 0; m < 4; ++m) { bf16_t* rowp = O + (size_t)(row0 + ai * HALF + m * 16) * ldc + col0;
                const f32x4 g0 = acc[ai][0][m][0], g1 = acc[ai][0][m][1], u0 = acc[ai][1][m][0], u1 = acc[ai][1][m][1];
                u32x4 w; w.x = cvt_pk_bf16(silu_mul(g0[0], u0[0]), silu_mul(g0[1], u0[1])); w.y = cvt_pk_bf16(silu_mul(g0[2], u0[2]), silu_mul(g0[3], u0[3]));
                w.z = cvt_pk_bf16(silu_mul(g1[0], u1[0]), silu_mul(g1[1], u1[1])); w.w = cvt_pk_bf16(silu_mul(g1[2], u1[2]), silu_mul(g1[3], u1[3]));
                *(u32x4*)rowp = w; }
    }
};
struct EpiRawSS {
    static constexpr bool PERM = true, AFTER_DRAIN = false;
    bf16_t* O; int ldc; float* rowpart;
    __device__ __forceinline__ void operator()(const f32x4 (&acc)[2][2][4][2], const Unit& u, int wr, int wc, int fr, int fq) const {
        const int row0 = u.pm * BM + wr * 64 + fr; const int col0 = u.pn * BM + wc * 32 + 8 * fq;
#pragma unroll
        for (int ai = 0; ai < 2; ++ai)
#pragma unroll
            for (int m = 0; m < 4; ++m) { const int row = row0 + ai * HALF + m * 16; bf16_t* rowp = O + (size_t)row * ldc + col0; float s = 0.f;
#pragma unroll
                for (int bj = 0; bj < 2; ++bj) { const f32x4 v0 = acc[ai][bj][m][0], v1 = acc[ai][bj][m][1];
                    s += (v0[0] * v0[0] + v0[1] * v0[1]) + (v0[2] * v0[2] + v0[3] * v0[3]) + (v1[0] * v1[0] + v1[1] * v1[1]) + (v1[2] * v1[2] + v1[3] * v1[3]);
                    u32x4 w; w.x = cvt_pk_bf16(v0[0], v0[1]); w.y = cvt_pk_bf16(v0[2], v0[3]); w.z = cvt_pk_bf16(v1[0], v1[1]); w.w = cvt_pk_bf16(v1[2], v1[3]);
                    *(u32x4*)(rowp + bj * HALF) = w; }
                s += __shfl_xor(s, 16); s += __shfl_xor(s, 32);
                if (fq == 0) rowpart[(size_t)row * 16 + u.pn * 4 + wc] = s; }
    }
};
struct EpiQKV {
    static constexpr bool PERM = true, AFTER_DRAIN = false;
    bf16_t* O; int ldc; float qscale;
    __device__ __forceinline__ void operator()(const f32x4 (&acc)[2][2][4][2], const Unit& u, int wr, int wc, int fr, int fq) const {
        const int row0 = u.pm * BM + wr * 64 + fr; const int col0 = u.pn * BM + wc * 32 + 8 * fq;
        const float sc = (u.pn < 2 || u.pn == 6 || u.pn == 7) ? qscale : 1.0f;
#pragma unroll
        for (int ai = 0; ai < 2; ++ai)
#pragma unroll
            for (int m = 0; m < 4; ++m) { const int row = row0 + ai * HALF + m * 16; bf16_t* rowp = O + (size_t)row * ldc + col0;
#pragma unroll
                for (int bj = 0; bj < 2; ++bj) { const f32x4 v0 = acc[ai][bj][m][0] * sc, v1 = acc[ai][bj][m][1] * sc;
                    u32x4 w; w.x = cvt_pk_bf16(v0[0], v0[1]); w.y = cvt_pk_bf16(v0[2], v0[3]); w.z = cvt_pk_bf16(v1[0], v1[1]); w.w = cvt_pk_bf16(v1[2], v1[3]);
                    *(u32x4*)(rowp + bj * HALF) = w; } }
    }
};
template <class Epi, class Sched, bool ALIGN_EPI = false, bool SP2 = false>
__device__ __forceinline__ void gemm_phase(PG8_LAS unsigned char* lds, const Gemm g, const Sched& S, const Epi& E) {
    const int tid = threadIdx.x, wid = __builtin_amdgcn_readfirstlane(tid >> 6), lane = tid & 63, wr = wid >> 2, wc = wid & 3, fr = lane & 15, fq = lane >> 4;
    const int K = g.K, nt = K / BK;
    unsigned voffA[2], voffB[2];
#pragma unroll
    for (int i = 0; i < 2; ++i) { int R, C; stage_rc(tid * 16 + i * 8192, R, C); const int Rb = Epi::PERM ? ((R & ~31) + perm32(R & 31)) : R;
        voffA[i] = (unsigned)(R * K + C) * 2u; voffB[i] = (unsigned)(Rb * K + C) * 2u; }
    const size_t kstep = (size_t)(BK * 2);
    const size_t hstep = (size_t)HALF * K * 2;
    const size_t tstep = 2 * hstep;
    const unsigned ldsw = (unsigned)wid * 1024u;
    const int aoff = lds_byte(wr * 64 + fr, fq * 8), boff = lds_byte(wc * 32 + fr, fq * 8);
#define PG8_SA(b, h) (((b) * 2 + (h)) * HTB)
#define PG8_SB(b, h) ((4 + (b) * 2 + (h)) * HTB)
#define PG8_STAGE(bufoff, gbase, voff) do { _Pragma("unroll") for (int _i = 0; _i < 2; ++_i) \
        __builtin_amdgcn_global_load_lds((const unsigned*)((const char*)(gbase) + (voff)[_i]), (PG8_LAS unsigned*)(lds + (bufoff) + ldsw + _i * 8192), 16, 0, 0); } while (0)
#define PG8_LDA(dst, b, h) do { _Pragma("unroll") for (int m = 0; m < 4; ++m) _Pragma("unroll") for (int k = 0; k < 2; ++k) dst[m][k] = *(const PG8_LAS bf16x8*)(lds + PG8_SA(b, h) + aoff + m * 2048 + k * 1024); } while (0)
#define PG8_LDB(dst, b, h) do { _Pragma("unroll") for (int n = 0; n < 2; ++n) _Pragma("unroll") for (int k = 0; k < 2; ++k) dst[n][k] = *(const PG8_LAS bf16x8*)(lds + PG8_SB(b, h) + boff + n * 2048 + k * 1024); } while (0)
#define PG8_MMA(ai, bj, At, Bt) do { __builtin_amdgcn_s_setprio(1); _Pragma("unroll") for (int m = 0; m < 4; ++m) _Pragma("unroll") for (int n = 0; n < 2; ++n) _Pragma("unroll") for (int k = 0; k < 2; ++k) \
        acc[ai][bj][m][n] = __builtin_amdgcn_mfma_f32_16x16x32_bf16(Bt[n][k], At[m][k], acc[ai][bj][m][n], 0, 0, 0); __builtin_amdgcn_s_setprio(0); } while (0)
#define PG8_WAIT_V(n) asm volatile("s_waitcnt vmcnt(" #n ")" ::: "memory")
#define PG8_WAIT_L(n) asm volatile("s_waitcnt lgkmcnt(" #n ")" ::: "memory")
#define PG8_BAR __builtin_amdgcn_s_barrier()
#define PG8_SCHED __builtin_amdgcn_sched_barrier(0)
    Unit cur, nxt; int ui = 0;
    if (!S.next(0, cur)) return;
    f32x4 acc[2][2][4][2];
#pragma unroll
    for (int a = 0; a < 2; ++a)
#pragma unroll
        for (int b = 0; b < 2; ++b)
#pragma unroll
            for (int m = 0; m < 4; ++m)
#pragma unroll
                for (int n = 0; n < 2; ++n) acc[a][b][m][n] = (f32x4){0.f, 0.f, 0.f, 0.f};
    bf16x8 At[4][2], B0[2][2], B1[2][2];
    const char* cA = (const char*)g.A + (size_t)cur.pm * tstep; const char* cB = (const char*)g.Bt + (size_t)cur.pn * tstep;
    S.a_ready(cur);
    if constexpr (SP2) {
        PG8_STAGE(PG8_SB(0, 0), cB, voffB); PG8_STAGE(PG8_SB(0, 1), cB + hstep, voffB); PG8_STAGE(PG8_SA(0, 0), cA, voffA); PG8_STAGE(PG8_SA(0, 1), cA + hstep, voffA);
        if (wr == 1) PG8_BAR;
        PG8_WAIT_V(2); PG8_BAR;
        PG8_STAGE(PG8_SB(1, 0), cB + kstep, voffB); PG8_STAGE(PG8_SA(1, 0), cA + kstep, voffA); PG8_STAGE(PG8_SB(1, 1), cB + hstep + kstep, voffB);
        PG8_WAIT_V(6); PG8_BAR;
    } else {
        PG8_STAGE(PG8_SB(0, 0), cB, voffB); PG8_STAGE(PG8_SA(0, 0), cA, voffA); PG8_STAGE(PG8_SB(0, 1), cB + hstep, voffB); PG8_STAGE(PG8_SA(0, 1), cA + hstep, voffA);
        if (wr == 1) PG8_BAR;
        PG8_WAIT_V(4); PG8_BAR;
        PG8_STAGE(PG8_SB(1, 0), cB + kstep, voffB); PG8_STAGE(PG8_SA(1, 0), cA + kstep, voffA); PG8_STAGE(PG8_SB(1, 1), cB + hstep + kstep, voffB);
        PG8_WAIT_V(6); PG8_BAR;
    }
    for (;;) {
        const bool has_next = S.next(ui + 1, nxt);
        const char* nA = has_next ? (const char*)g.A + (size_t)nxt.pm * tstep : cA; const char* nB = has_next ? (const char*)g.Bt + (size_t)nxt.pn * tstep : cB;
        for (int t = 0; t < nt; t += 2) {
            const bool last = (t == nt - 2);
            const char* a1 = cA + (size_t)(t + 1) * kstep;
            const char* a2 = last ? nA : cA + (size_t)(t + 2) * kstep; const char* b2 = last ? nB : cB + (size_t)(t + 2) * kstep;
            const char* a3 = a2 + kstep; const char* b3 = b2 + kstep;
            if (last && has_next) S.a_ready(nxt);
            if constexpr (SP2) {
            PG8_LDB(B0, 0, 0); PG8_LDB(B1, 0, 1); PG8_SCHED; PG8_LDA(At, 0, 0); PG8_STAGE(PG8_SA(1, 1), a1 + hstep, voffA);
            PG8_WAIT_V(8); PG8_WAIT_L(0); PG8_BAR; PG8_MMA(0, 0, At, B0); PG8_MMA(0, 1, At, B1); PG8_BAR; PG8_SCHED;
            PG8_LDA(At, 0, 1); PG8_STAGE(PG8_SB(0, 0), b2, voffB); PG8_STAGE(PG8_SB(0, 1), b2 + hstep, voffB); PG8_STAGE(PG8_SA(0, 0), a2, voffA);
            PG8_WAIT_V(8); PG8_WAIT_L(0); PG8_BAR; PG8_MMA(1, 0, At, B0); PG8_MMA(1, 1, At, B1); PG8_BAR; PG8_SCHED;
            PG8_LDB(B0, 1, 0); PG8_LDB(B1, 1, 1); PG8_SCHED; PG8_LDA(At, 1, 0); PG8_STAGE(PG8_SA(0, 1), a2 + hstep, voffA);
            PG8_WAIT_V(8); PG8_WAIT_L(0); PG8_BAR; PG8_MMA(0, 0, At, B0); PG8_MMA(0, 1, At, B1); PG8_BAR; PG8_SCHED;
            PG8_LDA(At, 1, 1); PG8_STAGE(PG8_SB(1, 0), b3, voffB); PG8_STAGE(PG8_SB(1, 1), b3 + hstep, voffB); PG8_STAGE(PG8_SA(1, 0), a3, voffA);
            PG8_WAIT_V(8); PG8_WAIT_L(0); PG8_BAR; PG8_MMA(1, 0, At, B0); PG8_MMA(1, 1, At, B1); PG8_BAR; PG8_SCHED;
            } else {
            PG8_LDB(B0, 0, 0); PG8_SCHED; PG8_LDA(At, 0, 0); PG8_STAGE(PG8_SA(1, 1), a1 + hstep, voffA);
            PG8_WAIT_L(8); PG8_BAR; PG8_WAIT_L(0); PG8_MMA(0, 0, At, B0); PG8_BAR; PG8_SCHED;
            PG8_LDB(B1, 0, 1); PG8_STAGE(PG8_SB(0, 0), b2, voffB);
            PG8_BAR; PG8_WAIT_L(0); PG8_MMA(0, 1, At, B1); PG8_BAR;
            PG8_LDA(At, 0, 1); PG8_STAGE(PG8_SA(0, 0), a2, voffA);
            PG8_BAR; PG8_WAIT_L(0); PG8_MMA(1, 0, At, B0); PG8_BAR; PG8_SCHED;
            PG8_STAGE(PG8_SB(0, 1), b2 + hstep, voffB);
            PG8_WAIT_V(6); PG8_BAR; PG8_MMA(1, 1, At, B1); PG8_BAR;
            PG8_LDB(B0, 1, 0); PG8_SCHED; PG8_LDA(At, 1, 0); PG8_STAGE(PG8_SA(0, 1), a2 + hstep, voffA);
            PG8_WAIT_L(8); PG8_BAR; PG8_WAIT_L(0); PG8_MMA(0, 0, At, B0); PG8_BAR; PG8_SCHED;
            PG8_LDB(B1, 1, 1); PG8_STAGE(PG8_SB(1, 0), b3, voffB);
            PG8_BAR; PG8_WAIT_L(0); PG8_MMA(0, 1, At, B1); PG8_BAR;
            PG8_LDA(At, 1, 1); PG8_STAGE(PG8_SA(1, 0), a3, voffA);
            PG8_BAR; PG8_WAIT_L(0); PG8_MMA(1, 0, At, B0); PG8_BAR; PG8_SCHED;
            PG8_STAGE(PG8_SB(1, 1), b3 + hstep, voffB);
            PG8_WAIT_V(6); PG8_BAR; PG8_MMA(1, 1, At, B1); PG8_BAR;
            }
        }
        if constexpr (ALIGN_EPI) { if (wr == 0) PG8_BAR; }
        if constexpr (!Epi::AFTER_DRAIN) { E(acc, cur, wr, wc, fr, fq); S.done(cur); }
        if (!has_next) break;
#pragma unroll
        for (int a = 0; a < 2; ++a)
#pragma unroll
            for (int b = 0; b < 2; ++b)
#pragma unroll
                for (int m = 0; m < 4; ++m)
#pragma unroll
                    for (int n = 0; n < 2; ++n) acc[a][b][m][n] = (f32x4){0.f, 0.f, 0.f, 0.f};
        cur = nxt; cA = nA; cB = nB; ++ui;
        if constexpr (ALIGN_EPI) { if (wr == 1) PG8_BAR; }
    }
    PG8_WAIT_V(0);
    if constexpr (!ALIGN_EPI) { if (wr == 0) PG8_BAR; }
    PG8_BAR;
    if constexpr (Epi::AFTER_DRAIN) { E.fused(acc, cur, wr, wc, fr, fq, lds, wid, lane); S.done(cur); }
#undef PG8_SA
#undef PG8_SB
#undef PG8_STAGE
#undef PG8_LDA
#undef PG8_LDB
#undef PG8_MMA
#undef PG8_WAIT_V
#undef PG8_WAIT_L
#undef PG8_BAR
#undef PG8_SCHED
}
}
namespace att {
#define ATT_LAS __attribute__((address_space(3)))
typedef unsigned short bf16_t;
typedef short bf16x8 __attribute__((ext_vector_type(8)));
typedef short s16x4 __attribute__((ext_vector_type(4)));
typedef float f32x16 __attribute__((ext_vector_type(16)));
typedef unsigned u32x4 __attribute__((ext_vector_type(4)));
typedef unsigned u32x2 __attribute__((ext_vector_type(2)));
constexpr int QKV_LD = 2304, O_LD = 1024, SEQ = 2048, CHUNK = 64;
constexpr int BT_STRIDE = 324;
constexpr int KROW = 144, KTILE = 64 * KROW, VTILE = 8192, LDS_V = 4 * KTILE, LDS_BT = LDS_V + 4 * VTILE, LDS_END = LDS_BT + 8 * BT_STRIDE * 4;
constexpr float THR = 8.0f;
__device__ __forceinline__ int crow(int r, int hi) { return (r & 3) + 8 * (r >> 2) + 4 * hi; }
__device__ __forceinline__ unsigned cvtpk(float lo, float hi) { unsigned r; asm volatile("v_cvt_pk_bf16_f32 %0, %1, %2" : "=v"(r) : "v"(lo), "v"(hi)); return r; }
__device__ __forceinline__ s16x4 vtr(const ATT_LAS unsigned char* p) { return __builtin_bit_cast(s16x4, __builtin_amdgcn_ds_read_tr16_b64_v4i16((ATT_LAS s16x4*)p)); }

template <int KIND>
__device__ __forceinline__ void attn_prefetch(const bf16_t* __restrict__ QKV, int b, int c, int g, u32x4 (&kr)[4], u32x4 (&vr)[4], bf16x8 (&q)[4], int tid) {
    constexpr int L = KIND == 0 ? 8 : 2, NH = KIND == 0 ? 4 : 1;
    const int lane = tid & 63, wave = tid >> 6, r32 = lane & 31, hi = lane >> 5;
    const int h = 4 * g + (wave >> 1), qhalf = wave & 1;
    const int qcol = KIND == 0 ? h * 64 : 1536 + h * 64;
    const int kcol0 = KIND == 0 ? 512 + 256 * g : 2048 + 64 * g, vcol0 = KIND == 0 ? 1024 + 256 * g : 2176 + 64 * g;
    const long tok0 = (long)b * SEQ + c * CHUNK;
    const int j0 = (L - c) > 0 ? (L - c) : 0;
    const int lrow = tid >> 3, lch = tid & 7;
    const bf16_t* kg = QKV + (size_t)(tok0 - L * CHUNK + lrow + j0 * 64) * QKV_LD + kcol0 + 8 * lch;
    const bf16_t* vg = QKV + (size_t)(tok0 - L * CHUNK + lrow + j0 * 64) * QKV_LD + vcol0 + 8 * lch;
#pragma unroll
    for (int i = 0; i < NH; ++i) { kr[i] = *(const u32x4*)(kg + 64 * i); vr[i] = *(const u32x4*)(vg + 64 * i); }
    const bf16_t* qp = QKV + (size_t)(tok0 + qhalf * 32 + r32) * QKV_LD + qcol + 8 * hi;
#pragma unroll
    for (int d0 = 0; d0 < 4; ++d0) q[d0] = *(const bf16x8*)(qp + 16 * d0);
}
template <int KIND, int NKIND>
__device__ __forceinline__ void attn_round(const bf16_t* __restrict__ QKV, bf16_t* __restrict__ O, int b, int c, int g, int nb, int nc, int ng, u32x4 (&kr)[4], u32x4 (&vr)[4], bf16x8 (&qr)[4],
                                           ATT_LAS unsigned char* lds, const float* sinks, int tid) {
    constexpr int L = KIND == 0 ? 8 : 2, NH = KIND == 0 ? 4 : 1;
    const int lane = tid & 63, wave = tid >> 6, r32 = lane & 31, hi = lane >> 5;
    const int h = 4 * g + (wave >> 1), qhalf = wave & 1, hs = KIND == 0 ? (wave >> 1) : 0;
    const int ocol = KIND == 0 ? h * 64 : 512 + h * 64;
    const int kcol0 = KIND == 0 ? 512 + 256 * g : 2048 + 64 * g;
    const int vcol0 = KIND == 0 ? 1024 + 256 * g : 2176 + 64 * g;
    const long tok0 = (long)b * SEQ + c * CHUNK;
    const int j0 = (L - c) > 0 ? (L - c) : 0;
    const int lrow = tid >> 3, lch = tid & 7;
    const bf16_t* kg = QKV + (size_t)(tok0 - L * CHUNK + lrow) * QKV_LD + kcol0 + 8 * lch;
    const bf16_t* vg = QKV + (size_t)(tok0 - L * CHUNK + lrow) * QKV_LD + vcol0 + 8 * lch;
    const int kw = lrow * KROW + lch * 16;
    const int vw = LDS_V + (lch >> 2) * 4096 + (lrow >> 4) * 1024 + ((lrow >> 3) & 1) * 512 + (lrow & 7) * 64 + (lch & 3) * 16;
    bf16x8 qn[4];
#pragma unroll
    for (int d0 = 0; d0 < 4; ++d0) qn[d0] = qr[d0];
    const ATT_LAS unsigned char* kl = lds + hs * KTILE + r32 * KROW + 16 * hi;
    const ATT_LAS unsigned char* vl = lds + LDS_V + hs * VTILE + (4 * hi + ((lane & 15) >> 2)) * 64 + ((lane >> 4) & 1) * 32 + (lane & 3) * 8;
    const ATT_LAS float* bt = (const ATT_LAS float*)(lds + LDS_BT) + h * BT_STRIDE;
    float m = KIND == 0 ? 0.0f : sinks[h] * 1.4426950408889634f, l = (KIND == 1 && hi == 0) ? 1.0f : 0.0f;
    f32x16 o[2]; o[0] = f32x16{}; o[1] = f32x16{};
    const float cb = KIND == 0 ? bt[256] : 0.f;
    f32x16 csp;
#pragma unroll
    for (int r = 0; r < 16; ++r) csp[r] = cb - m;
    const int iq = qhalf * 32 + r32;
    for (int j = j0; j <= L; ++j) {
        __syncthreads();
#pragma unroll
        for (int i = 0; i < NH; ++i) { *(ATT_LAS u32x4*)(lds + i * KTILE + kw) = kr[i]; *(ATT_LAS u32x4*)(lds + i * VTILE + vw) = vr[i]; }
        __syncthreads();
        if (j < L) {
#pragma unroll
            for (int i = 0; i < NH; ++i) { kr[i] = *(const u32x4*)(kg + (size_t)((j + 1) * 64) * QKV_LD + 64 * i); vr[i] = *(const u32x4*)(vg + (size_t)((j + 1) * 64) * QKV_LD + 64 * i); }
        } else if (NKIND >= 0) { attn_prefetch<NKIND < 0 ? 0 : NKIND>(QKV, nb, nc, ng, kr, vr, qn, tid); }
        f32x16 p[2];
        if (KIND == 0 && j >= 6) {
            const ATT_LAS float* btl = bt + (640 + iq - 4 * hi - 64 * j);
#pragma unroll
            for (int kb = 0; kb < 2; ++kb)
#pragma unroll
                for (int r = 0; r < 16; ++r) p[kb][r] = btl[-(32 * kb + (r & 3) + 8 * (r >> 2))] - m;
#pragma unroll
            for (int kb = 0; kb < 2; ++kb)
#pragma unroll
                for (int d0 = 0; d0 < 4; ++d0) { const bf16x8 kf = *(const ATT_LAS bf16x8*)(kl + kb * 32 * KROW + d0 * 32); p[kb] = __builtin_amdgcn_mfma_f32_32x32x16_bf16(kf, qr[d0], p[kb], 0, 0, 0); }
        } else {
#pragma unroll
            for (int kb = 0; kb < 2; ++kb)
#pragma unroll
                for (int d0 = 0; d0 < 4; ++d0) { const bf16x8 kf = *(const ATT_LAS bf16x8*)(kl + kb * 32 * KROW + d0 * 32);
                    if (d0 == 0) p[kb] = __builtin_amdgcn_mfma_f32_32x32x16_bf16(kf, qr[d0], csp, 0, 0, 0); else p[kb] = __builtin_amdgcn_mfma_f32_32x32x16_bf16(kf, qr[d0], p[kb], 0, 0, 0); }
        }
        float mx = fmaxf(fmaxf(p[0][0], p[0][1]), p[1][0]);
#pragma unroll
        for (int r = 2; r < 16; r += 2) mx = fmaxf(fmaxf(mx, p[0][r]), p[0][r + 1]);
#pragma unroll
        for (int r = 1; r < 16; r += 2) mx = fmaxf(fmaxf(mx, p[1][r]), p[1][(r + 1) & 15]);
        mx = fmaxf(mx, __shfl_xor(mx, 32));
        if (KIND == 0 && j == j0) {
            m = mx;
#pragma unroll
            for (int r = 0; r < 16; ++r) { p[0][r] -= mx; p[1][r] -= mx; csp[r] = cb - m; }
        } else if (__any(mx > THR)) {
            const float dl = fmaxf(mx, 0.f), f = __builtin_amdgcn_exp2f(-dl); m += dl; l *= f;
#pragma unroll
            for (int r = 0; r < 16; ++r) { o[0][r] *= f; o[1][r] *= f; p[0][r] -= dl; p[1][r] -= dl; csp[r] = cb - m; }
        }
        float ls0 = 0.f, ls1 = 0.f;
#pragma unroll
        for (int r = 0; r < 16; ++r) { p[0][r] = __builtin_amdgcn_exp2f(p[0][r]); p[1][r] = __builtin_amdgcn_exp2f(p[1][r]); ls0 += p[0][r]; ls1 += p[1][r]; }
        l += ls0 + ls1;
#pragma unroll
        for (int ks = 0; ks < 4; ++ks) { const int kb = ks >> 1, s = ks & 1;
            u32x4 pw; pw.x = cvtpk(p[kb][8 * s + 0], p[kb][8 * s + 1]); pw.y = cvtpk(p[kb][8 * s + 2], p[kb][8 * s + 3]); pw.z = cvtpk(p[kb][8 * s + 4], p[kb][8 * s + 5]); pw.w = cvtpk(p[kb][8 * s + 6], p[kb][8 * s + 7]);
            const bf16x8 pa = __builtin_bit_cast(bf16x8, pw);
#pragma unroll
            for (int d0 = 0; d0 < 2; ++d0) { const s16x4 lo = vtr(vl + d0 * 4096 + ks * 1024), hh = vtr(vl + d0 * 4096 + ks * 1024 + 512);
                const bf16x8 vf = (bf16x8){lo[0], lo[1], lo[2], lo[3], hh[0], hh[1], hh[2], hh[3]};
                o[d0] = __builtin_amdgcn_mfma_f32_32x32x16_bf16(vf, pa, o[d0], 0, 0, 0); } }
    }
    l += __shfl_xor(l, 32);
    const float inv = 1.0f / l;
    bf16_t* op = O + (size_t)(tok0 + qhalf * 32 + r32) * O_LD + ocol + 4 * hi;
#pragma unroll
    for (int d0 = 0; d0 < 2; ++d0)
#pragma unroll
        for (int gq = 0; gq < 4; ++gq) { u32x2 w; w.x = cvtpk(o[d0][4 * gq] * inv, o[d0][4 * gq + 1] * inv); w.y = cvtpk(o[d0][4 * gq + 2] * inv, o[d0][4 * gq + 3] * inv);
            *(u32x2*)(op + 32 * d0 + 8 * gq) = w; }
#pragma unroll
    for (int d0 = 0; d0 < 4; ++d0) qr[d0] = qn[d0];
}
}
constexpr int NWAVES = 8;
#ifndef MK_PER_PHASE
#define MK_PER_PHASE 0
#endif
constexpr int NPHASE = 11;
constexpr int BATCH = 32, SEQ = 2048, D = 1024, FF = 2816, DIN = 2304, M = BATCH * SEQ;
constexpr float EPS = 1e-6f;
constexpr size_t MiB = 1u << 20;
constexpr size_t WS_W1GU = 2 * MiB, WS_W1D = 14 * MiB, WS_WIN = 20 * MiB, WS_WOUT = 25 * MiB, WS_W2GU = 28 * MiB, WS_W2D = 40 * MiB, WS_ROPE = 46 * MiB, WS_RPART = 50 * MiB;
constexpr size_t WS_XN = 64 * MiB;
constexpr size_t WS_ACT = 192 * MiB;
constexpr size_t WS_F = 544 * MiB;
constexpr size_t WS_H = 672 * MiB;
constexpr size_t WS_ROWR = 56 * MiB;
constexpr size_t WS_END = 800 * MiB;
constexpr int LDS_BYTES = 147456;
constexpr size_t WS_CTL = 0, CTL_ZERO_BYTES = 65536;
constexpr int CW_BAR = 4096;

#define LAS __attribute__((address_space(3)))
typedef unsigned short bf16;
typedef unsigned v4u __attribute__((ext_vector_type(4)));
typedef unsigned v2u __attribute__((ext_vector_type(2)));
typedef float f32x4 __attribute__((ext_vector_type(4)));
__device__ __forceinline__ unsigned pk2(float lo, float hi) { return pg8::cvt_pk_bf16(lo, hi); }
__device__ __forceinline__ float bf2f(unsigned short v) { return __uint_as_float((unsigned)v << 16); }
template <int CTRL> __device__ __forceinline__ float dpp_add(float v) { return v + __int_as_float(__builtin_amdgcn_update_dpp(0, __float_as_int(v), CTRL, 0xF, 0xF, true)); }
__device__ __forceinline__ float wave_sum(float v) {
    v = dpp_add<0xB1>(v); v = dpp_add<0x4E>(v); v = dpp_add<0x141>(v); v = dpp_add<0x140>(v);
    { auto rr = __builtin_amdgcn_permlane16_swap(__float_as_uint(v), __float_as_uint(v), false, false); v = __uint_as_float(rr[0]) + __uint_as_float(rr[1]); }
    { auto rr = __builtin_amdgcn_permlane32_swap(__float_as_uint(v), __float_as_uint(v), false, false); v = __uint_as_float(rr[0]) + __uint_as_float(rr[1]); }
    return v;
}
__device__ __forceinline__ void p0_transpose_item(const float* W, int K, int N, bf16* WT, int mode, LAS float* scr, int item, int lane) {
    const int nblk = N / 32, kb = item / nblk, nb = item % nblk, k0 = 64 * kb, n0 = 32 * nb;
    const int drow0 = mode == 0 ? n0 : ((n0 >> 7) * 256 + (n0 & 127) + (mode == 2 ? 128 : 0));
#pragma unroll 8
    for (int i = 0; i < 32; ++i) { const int kk = 2 * i + (lane >> 5); scr[kk * 33 + (lane & 31)] = W[(size_t)(k0 + kk) * N + n0 + (lane & 31)]; }
    asm volatile("s_waitcnt lgkmcnt(0)" ::: "memory");
    const int c = lane & 7;
#pragma unroll
    for (int j = 0; j < 4; ++j) { const int n = (lane >> 3) + 8 * j; const LAS float* s = scr + (8 * c) * 33 + n;
        v4u o; o.x = pk2(s[0 * 33], s[1 * 33]); o.y = pk2(s[2 * 33], s[3 * 33]); o.z = pk2(s[4 * 33], s[5 * 33]); o.w = pk2(s[6 * 33], s[7 * 33]);
        *(v4u*)(WT + (size_t)(drow0 + n) * K + k0 + 8 * c) = o; }
    asm volatile("s_waitcnt lgkmcnt(0)" ::: "memory");
}
#define XB_TMO      128
#define XB_XCNT(j)  (256  + 64 * (j))
#define XB_XSUB(j)  (1280 + 64 * (j))
#define XB_XGEN(j)  (2304 + 64 * (j))
#define XB_TOP      3328
#define XB_TOPGEN   3392
#define XCD_BAR_WORDS 3456
#define XB_SPIN_CAP (1u << 18)

__device__ __forceinline__ unsigned xb_ld(unsigned* p)              { return __hip_atomic_load(p, __ATOMIC_RELAXED, __HIP_MEMORY_SCOPE_AGENT); }
__device__ __forceinline__ unsigned xb_add(unsigned* p, unsigned v) { return __hip_atomic_fetch_add(p, v, __ATOMIC_RELAXED, __HIP_MEMORY_SCOPE_AGENT); }
__device__ __forceinline__ unsigned xb_xcc_id() { return (unsigned)__builtin_amdgcn_s_getreg((3 << 11) | 20) & 0xFu; }
#define XB_SPIN(cond, bar) do { unsigned _sp = 0; while (cond) { __builtin_amdgcn_s_sleep(1); \
    if ((++_sp & 255u) == 0u) { if (xb_ld(&(bar)[XB_TMO])) break; if (_sp > XB_SPIN_CAP) { atomicAdd(&(bar)[XB_TMO], 1u); break; } } } } while (0)

struct XcdBarrier {
    unsigned* bar; unsigned x;
    volatile LAS unsigned* st;
};

__device__ __forceinline__ XcdBarrier xcd_barrier_post(unsigned* bar, volatile LAS unsigned* st) {
    XcdBarrier b; b.bar = bar; b.x = xb_xcc_id(); b.st = st;
    if (threadIdx.x == 0) (void)xb_add(&bar[XB_XCNT(b.x)], 1u);
    return b;
}
__device__ __forceinline__ void xcd_barrier_complete(unsigned* bar, unsigned x, unsigned& nloc, unsigned& nx) {
    const unsigned G = gridDim.x * gridDim.y * gridDim.z;
    unsigned sum, cnt, mine, sp = 0u;
    for (;;) {
        sum = 0u; cnt = 0u; mine = 0u;
#pragma unroll
        for (unsigned j = 0; j < 16; ++j) { const unsigned c = xb_ld(&bar[XB_XCNT(j)]); sum += c; cnt += (c > 0u) ? 1u : 0u; mine = (j == x) ? c : mine; }
        if (sum == G) break;
        __builtin_amdgcn_s_sleep(1);
        if ((++sp & 255u) == 0u) { if (xb_ld(&bar[XB_TMO])) break; if (sp > XB_SPIN_CAP) { atomicAdd(&bar[XB_TMO], 1u); break; } }
    }
    nloc = mine > 0u ? mine : 1u; nx = cnt > 0u ? cnt : 1u;
}

__device__ __forceinline__ void xcd_barrier(const XcdBarrier& b) {
    asm volatile("s_waitcnt vmcnt(0)" ::: "memory");
    __syncthreads();
    if (threadIdx.x == 0) {
        unsigned* bar = b.bar;
        __builtin_amdgcn_s_waitcnt(0);
        unsigned nloc = b.st[0], nx = b.st[1];
        if (nloc == 0u) { xcd_barrier_complete(bar, b.x, nloc, nx); b.st[0] = nloc; b.st[1] = nx; }
        const unsigned old = xb_add(&bar[XB_XSUB(b.x)], 1u);
        const unsigned gen = old / nloc;
        if (old + 1u == (gen + 1u) * nloc) {
            __builtin_amdgcn_fence(__ATOMIC_RELEASE, "agent");
            asm volatile("s_waitcnt vmcnt(0)" ::: "memory");
            const unsigned og = xb_add(&bar[XB_TOP], 1u);
            const unsigned tg = og / nx;
            if (og + 1u == (tg + 1u) * nx) xb_add(&bar[XB_TOPGEN], 1u);
            else XB_SPIN(xb_ld(&bar[XB_TOPGEN]) == tg, bar);
            __builtin_amdgcn_fence(__ATOMIC_ACQUIRE, "agent");
            xb_add(&bar[XB_XGEN(b.x)], 1u);
            asm volatile("s_waitcnt vmcnt(0)" ::: "memory");
        } else {
            XB_SPIN(xb_ld(&bar[XB_XGEN(b.x)]) == gen, bar);
            __builtin_amdgcn_fence(__ATOMIC_ACQUIRE, "agent");
            asm volatile("s_waitcnt vmcnt(0)" ::: "memory");
        }
    }
    __syncthreads();
}

struct Args {
    const float* x; const int* pos; const float* g_pre1; const float* w1g; const float* w1u; const float* w1d; const float* g_post1; const float* g_mpre; const float* w_in; const float* relb;
    const float* sinks; const float* w_out; const float* g_mpost; const float* g_pre2; const float* w2g; const float* w2u; const float* w2d; const float* g_post2; const float* g_fin;
    float* out; unsigned char* ws; float invf[8]; int ph_lo, ph_hi;
};
__device__ __forceinline__ void rms_row_to_bf16(const float* xrow, const float* g, bf16* orow, int lane) {
    const f32x4* xr = (const f32x4*)xrow + lane; const f32x4* gr = (const f32x4*)g + lane;
    f32x4 v[4]; float s = 0.f;
#pragma unroll
    for (int j = 0; j < 4; ++j) { v[j] = xr[64 * j]; s += (v[j].x * v[j].x + v[j].y * v[j].y) + (v[j].z * v[j].z + v[j].w * v[j].w); }
    const float r = 1.0f / sqrtf(wave_sum(s) * (1.f / D) + EPS);
    v2u* o8 = (v2u*)orow + lane;
#pragma unroll
    for (int j = 0; j < 4; ++j) { const f32x4 gg = gr[64 * j]; v2u w; w.x = pk2(v[j].x * r * gg.x, v[j].y * r * gg.y); w.y = pk2(v[j].z * r * gg.z, v[j].w * r * gg.w); o8[64 * j] = w; }
}
__device__ __forceinline__ f32x4 ld_bf4(const bf16* p) { const v2u w = *(const v2u*)p; f32x4 r; r.x = __uint_as_float(w.x << 16); r.y = __uint_as_float(w.x & 0xffff0000u); r.z = __uint_as_float(w.y << 16); r.w = __uint_as_float(w.y & 0xffff0000u); return r; }
__device__ __forceinline__ void st_bf4(bf16* p, f32x4 v) { v2u w; w.x = pk2(v.x, v.y); w.y = pk2(v.z, v.w); *(v2u*)p = w; }
template <bool BF32, int R> struct RowBuf { f32x4 bf[BF32 ? R : 1][4]; v2u bh[BF32 ? 1 : R][4]; v2u f[R][4]; float ss[R], rp[R]; };
template <bool BF32, int R>
__device__ __forceinline__ void fix_load(RowBuf<BF32, R>& B, int row0, const float* basef, const bf16* F, const float* rpart, const float* rowr, const bf16* xn, int lane) {
#pragma unroll
    for (int r = 0; r < R; ++r) { const size_t ro = (size_t)(row0 + r) * D + 4 * lane;
        B.ss[r] = lane < 16 ? rpart[(size_t)(row0 + r) * 16 + lane] : 0.f; B.rp[r] = BF32 ? 1.f : rowr[row0 + r];
#pragma unroll
        for (int j = 0; j < 4; ++j) { if (BF32) B.bf[r][j] = *(const f32x4*)(basef + ro + 256 * j); else B.bh[r][j] = *(const v2u*)(xn + ro + 256 * j); B.f[r][j] = *(const v2u*)(F + ro + 256 * j); } }
}
__device__ __forceinline__ f32x4 cv_bf4(v2u w) { f32x4 r; r.x = __uint_as_float(w.x << 16); r.y = __uint_as_float(w.x & 0xffff0000u); r.z = __uint_as_float(w.y << 16); r.w = __uint_as_float(w.y & 0xffff0000u); return r; }
template <int MODE, bool BF32, int R>
__device__ __forceinline__ void fix_compute(RowBuf<BF32, R>& B, int row0, float coef, const f32x4 (&gp)[4], const f32x4 (&gi)[4], const f32x4 (&gn)[4], float* rowr, bf16* xn, float* outf, int lane) {
#pragma unroll
    for (int r = 0; r < R; ++r) { const size_t ro = (size_t)(row0 + r) * D + 4 * lane;
        const float rf = coef / sqrtf(wave_sum(B.ss[r]) * (1.f / D) + EPS), rpi = BF32 ? 1.f : 1.0f / B.rp[r]; float s = 0.f; f32x4 h[4];
#pragma unroll
        for (int j = 0; j < 4; ++j) { const f32x4 bs = BF32 ? B.bf[r][j] : (cv_bf4(B.bh[r][j]) * rpi) * gi[j]; h[j] = bs + (cv_bf4(B.f[r][j]) * rf) * gp[j]; s += (h[j].x * h[j].x + h[j].y * h[j].y) + (h[j].z * h[j].z + h[j].w * h[j].w); }
        const float rh = 1.0f / sqrtf(wave_sum(s) * (1.f / D) + EPS);
        if (MODE == 0 && lane == 0) rowr[row0 + r] = rh;
#pragma unroll
        for (int j = 0; j < 4; ++j) { const f32x4 o = (h[j] * rh) * gn[j];
            if (MODE == 0) { st_bf4(xn + ro + 256 * j, o); } else { *(f32x4*)(outf + ro + 256 * j) = o; } } }
}
template <int MODE, bool BF32>
__device__ __forceinline__ void fix_phase(int gw, int NGW, const float* basef, const bf16* F, const float* rpart, float coef, const float* gpost, const float* gprev, const float* gnext, float* rowr, bf16* xn, float* outf, int lane) {
    constexpr int R = 2;
    f32x4 gp[4], gi[4], gn[4];
#pragma unroll
    for (int j = 0; j < 4; ++j) { gp[j] = *(const f32x4*)(gpost + 4 * lane + 256 * j); gn[j] = *(const f32x4*)(gnext + 4 * lane + 256 * j);
        if (!BF32) { const f32x4 gv = *(const f32x4*)(gprev + 4 * lane + 256 * j); gi[j] = (f32x4){1.0f / gv.x, 1.0f / gv.y, 1.0f / gv.z, 1.0f / gv.w}; } else gi[j] = (f32x4){1.f, 1.f, 1.f, 1.f}; }
    const int step = NGW * R; int m = gw * R;
    RowBuf<BF32, R> A, B;
    if (m < M) fix_load<BF32, R>(A, m, basef, F, rpart, rowr, xn, lane);
    for (; m < M; m += 2 * step) {
        if (m + step < M) fix_load<BF32, R>(B, m + step, basef, F, rpart, rowr, xn, lane);
        fix_compute<MODE, BF32, R>(A, m, coef, gp, gi, gn, rowr, xn, outf, lane);
        if (m + step < M) { if (m + 2 * step < M) fix_load<BF32, R>(A, m + 2 * step, basef, F, rpart, rowr, xn, lane);
            fix_compute<MODE, BF32, R>(B, m + step, coef, gp, gi, gn, rowr, xn, outf, lane); }
    }
}
__device__ __forceinline__ void p0_rows(int gw, int NGW, const float* x, const float* g, bf16* XN, int lane) {
    f32x4 gg[4];
#pragma unroll
    for (int j = 0; j < 4; ++j) gg[j] = *(const f32x4*)(g + 4 * lane + 256 * j);
    constexpr int R = 2; const int step = NGW * R; int m = gw * R;
    f32x4 A[R][4], B[R][4];
#define P0_LOAD(buf, mm) do { _Pragma("unroll") for (int r = 0; r < R; ++r) _Pragma("unroll") for (int j = 0; j < 4; ++j) buf[r][j] = *(const f32x4*)(x + (size_t)((mm) + r) * D + 4 * lane + 256 * j); } while (0)
#define P0_DO(buf, mm) do { _Pragma("unroll") for (int r = 0; r < R; ++r) { float s = 0.f; \
        _Pragma("unroll") for (int j = 0; j < 4; ++j) s += (buf[r][j].x * buf[r][j].x + buf[r][j].y * buf[r][j].y) + (buf[r][j].z * buf[r][j].z + buf[r][j].w * buf[r][j].w); \
        const float rr = 1.0f / sqrtf(wave_sum(s) * (1.f / D) + EPS); \
        _Pragma("unroll") for (int j = 0; j < 4; ++j) st_bf4(XN + (size_t)((mm) + r) * D + 4 * lane + 256 * j, (buf[r][j] * rr) * gg[j]); } } while (0)
    if (m < M) P0_LOAD(A, m);
    for (; m < M; m += 2 * step) {
        if (m + step < M) P0_LOAD(B, m + step);
        P0_DO(A, m);
        if (m + step < M) { if (m + 2 * step < M) P0_LOAD(A, m + 2 * step); P0_DO(B, m + step); }
    }
#undef P0_LOAD
#undef P0_DO
}

__global__ void __launch_bounds__(NWAVES * 64, 2) mk_fwd(Args a) {
    __builtin_assume(__builtin_amdgcn_workitem_id_y() == 0); __builtin_assume(__builtin_amdgcn_workitem_id_z() == 0);
    extern __shared__ __attribute__((aligned(16))) unsigned char lds_raw[];
    LAS unsigned char* lds = (LAS unsigned char*)lds_raw;
    const int tid = threadIdx.x, lane = tid & 63, wave = __builtin_amdgcn_readfirstlane(tid >> 6);
    const int G = gridDim.x, bx = blockIdx.x;
    const int vcu = (G % 8 == 0) ? (bx % 8) * (G / 8) + bx / 8 : bx;
    const int gw = vcu * NWAVES + wave, NGW = G * NWAVES;
    unsigned char* ws = a.ws;
    bf16* W1GU = (bf16*)(ws + WS_W1GU); bf16* W1D = (bf16*)(ws + WS_W1D); bf16* WIN = (bf16*)(ws + WS_WIN); bf16* WOUT = (bf16*)(ws + WS_WOUT); bf16* W2GU = (bf16*)(ws + WS_W2GU); bf16* W2D = (bf16*)(ws + WS_W2D);
    float* ROPE = (float*)(ws + WS_ROPE); float* RPART = (float*)(ws + WS_RPART);
    bf16* XN = (bf16*)(ws + WS_XN); bf16* ACT = (bf16*)(ws + WS_ACT); bf16* QKV = (bf16*)(ws + WS_ACT); bf16* OB = (bf16*)(ws + WS_H); bf16* FB = (bf16*)(ws + WS_F);
    float* ROWR = (float*)(ws + WS_ROWR);
    const int lo = a.ph_lo, hi = a.ph_hi;
    volatile LAS unsigned* MISC = (volatile LAS unsigned*)(lds + LDS_BYTES - 64);
    if (tid < 16) MISC[tid] = 0u;
    __syncthreads();
    XcdBarrier bar = xcd_barrier_post((unsigned*)(ws + WS_CTL) + CW_BAR, MISC + 8);
#define IN(k) (lo <= (k) && (k) < hi)
#define SEAM(k) do { if (IN(k) && IN((k) + 1)) { if ((k) == 0) cg::this_grid().sync(); else xcd_barrier(bar); } } while (0)

    if (IN(0)) {
        LAS float* scr = (LAS float*)(lds + wave * 16384);
        constexpr int I_GU = (D / 64) * (FF / 32), I_DN = (FF / 64) * (D / 32), I_IN = (D / 64) * (DIN / 32), I_OUT = (D / 64) * (D / 32);
        constexpr int NITEMS = 4 * I_GU + 2 * I_DN + I_IN + I_OUT;
        for (int it = gw; it < NITEMS; it += NGW) {
            int r = it;
            if (r < I_GU) { p0_transpose_item(a.w1g, D, FF, W1GU, 1, scr, r, lane); continue; } r -= I_GU;
            if (r < I_GU) { p0_transpose_item(a.w1u, D, FF, W1GU, 2, scr, r, lane); continue; } r -= I_GU;
            if (r < I_GU) { p0_transpose_item(a.w2g, D, FF, W2GU, 1, scr, r, lane); continue; } r -= I_GU;
            if (r < I_GU) { p0_transpose_item(a.w2u, D, FF, W2GU, 2, scr, r, lane); continue; } r -= I_GU;
            if (r < I_DN) { p0_transpose_item(a.w1d, FF, D, W1D, 0, scr, r, lane); continue; } r -= I_DN;
            if (r < I_DN) { p0_transpose_item(a.w2d, FF, D, W2D, 0, scr, r, lane); continue; } r -= I_DN;
            if (r < I_IN) { p0_transpose_item(a.w_in, D, DIN, WIN, 0, scr, r, lane); continue; } r -= I_IN;
            p0_transpose_item(a.w_out, D, D, WOUT, 0, scr, r, lane);
        }
        for (int i = gw * 64 + lane; i < M * 8; i += NGW * 64) { const int tok = i >> 3, j = i & 7;
            const float ang = (float)a.pos[tok] * a.invf[j];
            const double rev = (double)ang * 0.15915494309189535; const float fr = (float)(rev - floor(rev));
            ROPE[(size_t)tok * 16 + j] = __builtin_amdgcn_cosf(fr); ROPE[(size_t)tok * 16 + 8 + j] = __builtin_amdgcn_sinf(fr); }
        p0_rows(gw, NGW, a.x, a.g_pre1, XN, lane);
    }
    SEAM(0);
    if (IN(1)) { pg8::Gemm g{XN, W1GU, M, 2 * FF, D}; pg8::StaticOrder S; S.init(M, 2 * FF, G, bx); pg8::EpiSwiglu E{ACT, FF};
        pg8::gemm_phase<pg8::EpiSwiglu, pg8::StaticOrder, true, true>(lds, g, S, E); }
    SEAM(1);
    if (IN(2)) { pg8::Gemm g{ACT, W1D, M, D, FF}; pg8::StaticOrder S; S.init(M, D, G, bx); pg8::EpiRawSS E{FB, D, RPART};
        pg8::gemm_phase<pg8::EpiRawSS, pg8::StaticOrder, true, true>(lds, g, S, E); }
    SEAM(2);
    if (IN(3)) fix_phase<0, true>(gw, NGW, a.x, FB, RPART, 0.5f, a.g_post1, nullptr, a.g_mpre, ROWR, XN, nullptr, lane);
    SEAM(3);
    if (IN(4)) { pg8::Gemm g{XN, WIN, M, DIN, D}; pg8::StaticOrder S; S.init(M, DIN, G, bx); pg8::EpiQKV E{QKV, DIN, 0.125f * 1.4426950408889634f};
        pg8::gemm_phase<pg8::EpiQKV, pg8::StaticOrder, true, true>(lds, g, S, E); }
    SEAM(4);
    if (IN(5)) {
        for (int i = (gw * 64 + lane); i < M * 10; i += NGW * 64) { const int tok = i / 10, hh = i - tok * 10;
            bf16* p = QKV + (size_t)tok * DIN + (hh < 8 ? 1536 + 64 * hh : 2048 + 64 * (hh - 8));
            const v4u a0 = *(const v4u*)p, a1 = *(const v4u*)(p + 8); const f32x4* rp = (const f32x4*)(ROPE + (size_t)tok * 16); const f32x4 c0 = rp[0], c1 = rp[1], s0 = rp[2], s1 = rp[3];
            float x1[8], x2[8];
#pragma unroll
            for (int k = 0; k < 4; ++k) { x1[2 * k] = __uint_as_float(a0[k] << 16); x1[2 * k + 1] = __uint_as_float(a0[k] & 0xffff0000u); x2[2 * k] = __uint_as_float(a1[k] << 16); x2[2 * k + 1] = __uint_as_float(a1[k] & 0xffff0000u); }
            const float cs[8] = {c0.x, c0.y, c0.z, c0.w, c1.x, c1.y, c1.z, c1.w}, sn[8] = {s0.x, s0.y, s0.z, s0.w, s1.x, s1.y, s1.z, s1.w};
            v4u o0, o1;
#pragma unroll
            for (int k = 0; k < 4; ++k) { o0[k] = pk2(x1[2 * k] * cs[2 * k] - x2[2 * k] * sn[2 * k], x1[2 * k + 1] * cs[2 * k + 1] - x2[2 * k + 1] * sn[2 * k + 1]);
                o1[k] = pk2(x2[2 * k] * cs[2 * k] + x1[2 * k] * sn[2 * k], x2[2 * k + 1] * cs[2 * k + 1] + x1[2 * k + 1] * sn[2 * k + 1]); }
            *(v4u*)p = o0; *(v4u*)(p + 8) = o1; }
        xcd_barrier(bar);
        LAS float* bt = (LAS float*)(lds + att::LDS_BT);
        if (tid < 8) bt[8 * att::BT_STRIDE + tid] = a.sinks[tid] * 1.4426950408889634f;
        for (int i = tid; i < 8 * 320; i += NWAVES * 64) { const int hh = i / 320, k = i % 320; bt[hh * att::BT_STRIDE + k] = a.relb[hh * 257 + (k < 256 ? k : 256)] * 1.4426950408889634f; }
        __syncthreads();
        { att::u32x4 kr[4], vr[4]; att::bf16x8 qr[4];
#pragma unroll
          for (int i = 0; i < 4; ++i) { kr[i] = (att::u32x4){0u, 0u, 0u, 0u}; vr[i] = kr[i]; }
          if (vcu < BATCH * 32) { const int c = ((vcu & 7) + 8 * (vcu >> 8)) & 31, b = (vcu >> 3) & 31; att::attn_prefetch<0>(QKV, b, c, 0, kr, vr, qr, tid); }
          for (int u = vcu; u < BATCH * 32; u += G) {
            const int c = ((u & 7) + 8 * (u >> 8)) & 31, b = (u >> 3) & 31;
            const int un = u + G; const bool more = un < BATCH * 32; const int cn = ((un & 7) + 8 * (un >> 8)) & 31, bn = (un >> 3) & 31;
            att::attn_round<0, -1>(QKV, OB, b, c, 0, b, c, 1, kr, vr, qr, lds, a.sinks, tid); att::attn_prefetch<0>(QKV, b, c, 1, kr, vr, qr, tid);
            att::attn_round<0, -1>(QKV, OB, b, c, 1, b, c, 0, kr, vr, qr, lds, a.sinks, tid); att::attn_prefetch<1>(QKV, b, c, 0, kr, vr, qr, tid);
            att::attn_round<1, -1>(QKV, OB, b, c, 0, b, c, 1, kr, vr, qr, lds, a.sinks, tid); att::attn_prefetch<1>(QKV, b, c, 1, kr, vr, qr, tid);
            att::attn_round<1, -1>(QKV, OB, b, c, 1, 0, 0, 0, kr, vr, qr, lds, a.sinks, tid); if (more) att::attn_prefetch<0>(QKV, bn, cn, 0, kr, vr, qr, tid);
          } }
        __syncthreads();
    }
    SEAM(5);
    if (IN(6)) { pg8::Gemm g{OB, WOUT, M, D, D}; pg8::StaticOrder S; S.init(M, D, G, bx); pg8::EpiRawSS E{FB, D, RPART};
        pg8::gemm_phase<pg8::EpiRawSS, pg8::StaticOrder, true, true>(lds, g, S, E); }
    SEAM(6);
    if (IN(7)) fix_phase<0, false>(gw, NGW, nullptr, FB, RPART, 1.0f, a.g_mpost, a.g_mpre, a.g_pre2, ROWR, XN, nullptr, lane);
    SEAM(7);
    if (IN(8)) { pg8::Gemm g{XN, W2GU, M, 2 * FF, D}; pg8::StaticOrder S; S.init(M, 2 * FF, G, bx); pg8::EpiSwiglu E{ACT, FF};
        pg8::gemm_phase<pg8::EpiSwiglu, pg8::StaticOrder, true, true>(lds, g, S, E); }
    SEAM(8);
    if (IN(9)) { pg8::Gemm g{ACT, W2D, M, D, FF}; pg8::StaticOrder S; S.init(M, D, G, bx); pg8::EpiRawSS E{FB, D, RPART};
        pg8::gemm_phase<pg8::EpiRawSS, pg8::StaticOrder, true, true>(lds, g, S, E); }
    SEAM(9);
    if (IN(10)) fix_phase<1, false>(gw, NGW, nullptr, FB, RPART, 0.5f, a.g_post2, a.g_pre2, a.g_fin, ROWR, XN, a.out, lane);
#undef IN
#undef SEAM
}

extern "C" void kernel_launch(void* const* d_in, const int* in_sizes, int n_in, void* d_out, int out_size, void* d_ws, size_t ws_size, hipStream_t stream) {
    static int grid = 0;
    if (grid == 0) {
        if (n_in != 19 || in_sizes[0] != M * D || out_size != M * D || ws_size < WS_END) { fprintf(stderr, "kernel_launch: unexpected shapes (n_in %d, in0 %d, out %d, ws %zu)\n", n_in, n_in > 0 ? in_sizes[0] : -1, out_size, ws_size); grid = -1; return; }
        int dev = 0, cus = 0, per_cu = 0;
        if (hipGetDevice(&dev) != hipSuccess || hipDeviceGetAttribute(&cus, hipDeviceAttributeMultiprocessorCount, dev) != hipSuccess) { grid = -1; return; }
        if (hipFuncSetAttribute((const void*)mk_fwd, hipFuncAttributeMaxDynamicSharedMemorySize, LDS_BYTES) != hipSuccess) { fprintf(stderr, "kernel_launch: hipFuncSetAttribute failed\n"); grid = -1; return; }
        if (hipOccupancyMaxActiveBlocksPerMultiprocessor(&per_cu, (const void*)mk_fwd, NWAVES * 64, LDS_BYTES) != hipSuccess || per_cu < 1) { fprintf(stderr, "kernel_launch: occupancy query says %d\n", per_cu); per_cu = 1; }
        (void)hipGetLastError();
        grid = cus * 1;
    }
    if (grid < 0) return;
    if (hipMemsetAsync((char*)d_ws + WS_CTL, 0, CTL_ZERO_BYTES, stream) != hipSuccess) { fprintf(stderr, "kernel_launch: memset failed\n"); return; }
    Args a{};
    a.x = (const float*)d_in[0]; a.pos = (const int*)d_in[1]; a.g_pre1 = (const float*)d_in[2]; a.w1g = (const float*)d_in[3]; a.w1u = (const float*)d_in[4]; a.w1d = (const float*)d_in[5];
    a.g_post1 = (const float*)d_in[6]; a.g_mpre = (const float*)d_in[7]; a.w_in = (const float*)d_in[8]; a.relb = (const float*)d_in[9]; a.sinks = (const float*)d_in[10]; a.w_out = (const float*)d_in[11];
    a.g_mpost = (const float*)d_in[12]; a.g_pre2 = (const float*)d_in[13]; a.w2g = (const float*)d_in[14]; a.w2u = (const float*)d_in[15]; a.w2d = (const float*)d_in[16]; a.g_post2 = (const float*)d_in[17]; a.g_fin = (const float*)d_in[18];
    a.out = (float*)d_out; a.ws = (unsigned char*)d_ws;
    for (int j = 0; j < 8; ++j) a.invf[j] = (float)std::pow(500000.0, -(double)j / 8.0);
#if MK_PER_PHASE
    for (int p = 0; p < NPHASE; ++p) { a.ph_lo = p; a.ph_hi = p + 1; hipLaunchKernelGGL(mk_fwd, dim3(grid), dim3(NWAVES * 64), LDS_BYTES, stream, a); }
#else
    a.ph_lo = 0; a.ph_hi = NPHASE;
    void* args[] = {&a};
    hipError_t e = hipLaunchCooperativeKernel((const void*)mk_fwd, dim3(grid), dim3(NWAVES * 64), args, LDS_BYTES, stream);
    if (e != hipSuccess) fprintf(stderr, "cooperative launch failed: %s (grid %d)\n", hipGetErrorString(e), grid);
#endif
}
```

```cpp
#include <hip/hip_runtime.h>
#include <hip/hip_cooperative_groups.h>
#include <cstdio>
#include <cstdint>
#include <cmath>
namespace cg = cooperative_groups;
namespace pg8 {
#define PG8_LAS __attribute__((address_space(3)))
typedef unsigned short bf16_t;
typedef short bf16x8 __attribute__((ext_vector_type(8)));
typedef float f32x4 __attribute__((ext_vector_type(4)));
typedef unsigned u32x4 __attribute__((ext_vector_type(4)));
constexpr int BM = 256, BK = 64, HALF = 128, HTB = HALF * BK * 2  , STAGE_BYTES = 8 * HTB, NXCD = 8, WGM = 8;

__host__ __device__ __forceinline__ int lds_byte(int r, int c) { const int st = (r >> 4) * 2 + (c >> 5), rr = r & 15, cc = c & 31, ob = rr * 64 + cc * 2; return st * 1024 + (ob ^ (((ob >> 9) & 1) << 5)); }
__host__ __device__ __forceinline__ void stage_rc(int b, int& R, int& C) { const int st = b / 1024, sb = b % 1024, swz = sb ^ (((sb >> 9) & 1) << 5); R = (st >> 1) * 16 + swz / 64; C = (st & 1) * 32 + (swz % 64) / 2; }
__host__ __device__ __forceinline__ int perm32(int rho) { const int n = rho >> 4, i = rho & 15; return 8 * (i >> 2) + 4 * n + (i & 3); }

struct Unit { int pm, pn; };
struct Gemm { const bf16_t* A; const bf16_t* Bt; int M, N, K; };

struct StaticOrder {
    int nM, nN, nwg, G, c;
    __host__ __device__ void init(int M, int N, int G_, int c_) { nM = M / BM; nN = N / BM; nwg = nM * nN; G = G_; c = c_; }
    __host__ __device__ bool next(int i, Unit& u) const {
        const long L = (long)i * G + c; if (L >= nwg) return false;
        int wgid = (int)L; { const int q = nwg / NXCD, r = nwg % NXCD, xcd = wgid % NXCD, off = wgid / NXCD; wgid = (xcd < r ? xcd * (q + 1) : r * (q + 1) + (xcd - r) * q) + off; }
        const int nig = WGM * nN, gid = wgid / nig, fm = gid * WGM, gsz = (nM - fm) < WGM ? (nM - fm) : WGM;
        u.pm = fm + ((wgid % nig) % gsz); u.pn = (wgid % nig) / gsz; return true;
    }
    __device__ __forceinline__ void a_ready(const Unit&) const {}
    __device__ __forceinline__ void done(const Unit&) const {}
};

__device__ __forceinline__ unsigned cvt_pk_bf16(float lo, float hi) { unsigned r; asm volatile("v_cvt_pk_bf16_f32 %0, %1, %2" : "=v"(r) : "v"(lo), "v"(hi)); return r; }
__device__ __forceinline__ float silu_mul(float g, float u) { return g * u * __builtin_amdgcn_rcpf(1.0f + __builtin_amdgcn_exp2f(-1.4426950408889634f * g)); }
struct EpiSwiglu {
    static constexpr bool PERM = true, AFTER_DRAIN = false;
    bf16_t* O; int ldc;
    __device__ __forceinline__ void operator()(const f32x4 (&acc)[2][2][4][2], const Unit& u, int wr, int wc, int fr, int fq) const {
        const int row0 = u.pm * BM + wr * 64 + fr; const int col0 = u.pn * HALF + wc * 32 + 8 * fq;
#pragma unroll
        for (int ai = 0; ai < 2; ++ai)
#pragma unroll
            for (int m = 0; m < 4; ++m) { bf16_t* rowp = O + (size_t)(row0 + ai * HALF + m * 16) * ldc + col0;
                const f32x4 g0 = acc[ai][0][m][0], g1 = acc[ai][0][m][1], u0 = acc[ai][1][m][0], u1 = acc[ai][1][m][1];
                u32x4 w; w.x = cvt_pk_bf16(silu_mul(g0[0], u0[0]), silu_mul(g0[1], u0[1])); w.y = cvt_pk_bf16(silu_mul(g0[2], u0[2]), silu_mul(g0[3], u0[3]));
                w.z = cvt_pk_bf16(silu_mul(g1[0], u1[0]), silu_mul(g1[1], u1[1])); w.w = cvt_pk_bf16(silu_mul(g1[2], u1[2]), silu_mul(g1[3], u1[3]));
                *(u32x4*)rowp = w; }
    }
};
struct EpiRawSS {
    static constexpr bool PERM = true, AFTER_DRAIN = false;
    bf16_t* O; int ldc; float* rowpart;
    __device__ __forceinline__ void operator()(const f32x4 (&acc)[2][2][4][2], const Unit& u, int wr, int wc, int fr, int fq) const {
        const int row0 = u.pm * BM + wr * 64 + fr; const int col0 = u.pn * BM + wc * 32 + 8 * fq;
#pragma unroll
        for (int ai = 0; ai < 2; ++ai)
#pragma unroll
            for (int m = 0; m < 4; ++m) { const int row = row0 + ai * HALF + m * 16; bf16_t* rowp = O + (size_t)row * ldc + col0; float s = 0.f;
#pragma unroll
                for (int bj = 0; bj < 2; ++bj) { const f32x4 v0 = acc[ai][bj][m][0], v1 = acc[ai][bj][m][1];
                    s += (v0[0] * v0[0] + v0[1] * v0[1]) + (v0[2] * v0[2] + v0[3] * v0[3]) + (v1[0] * v1[0] + v1[1] * v1[1]) + (v1[2] * v1[2] + v1[3] * v1[3]);
                    u32x4 w; w.x = cvt_pk_bf16(v0[0], v0[1]); w.y = cvt_pk_bf16(v0[2], v0[3]); w.z = cvt_pk_bf16(v1[0], v1[1]); w.w = cvt_pk_bf16(v1[2], v1[3]);
                    *(u32x4*)(rowp + bj * HALF) = w; }
                s += __shfl_xor(s, 16); s += __shfl_xor(s, 32);
                if (fq == 0) rowpart[(size_t)row * 16 + u.pn * 4 + wc] = s; }
    }
};
struct EpiQKV {
    static constexpr bool PERM = true, AFTER_DRAIN = false;
    bf16_t* O; int ldc; float qscale;
    __device__ __forceinline__ void operator()(const f32x4 (&acc)[2][2][4][2], const Unit& u, int wr, int wc, int fr, int fq) const {
        const int row0 = u.pm * BM + wr * 64 + fr; const int col0 = u.pn * BM + wc * 32 + 8 * fq;
        const float sc = (u.pn < 2 || u.pn == 6 || u.pn == 7) ? qscale : 1.0f;
#pragma unroll
        for (int ai = 0; ai < 2; ++ai)
#pragma unroll
            for (int m = 0; m < 4; ++m) { const int row = row0 + ai * HALF + m * 16; bf16_t* rowp = O + (size_t)row * ldc + col0;
#pragma unroll
                for (int bj = 0; bj < 2; ++bj) { const f32x4 v0 = acc[ai][bj][m][0] * sc, v1 = acc[ai][bj][m][1] * sc;
                    u32x4 w; w.x = cvt_pk_bf16(v0[0], v0[1]); w.y = cvt_pk_bf16(v0[2], v0[3]); w.z = cvt_pk_bf16(v1[0], v1[1]); w.w = cvt_pk_bf16(v1[2], v1[3]);
                    *(u32x4*)(rowp + bj * HALF) = w; } }
    }
};
template <class Epi, class Sched, bool ALIGN_EPI = false, bool SP2 = false>
__device__ __forceinline__ void gemm_phase(PG8_LAS unsigned char* lds, const Gemm g, const Sched& S, const Epi& E) {
    const int tid = threadIdx.x, wid = __builtin_amdgcn_readfirstlane(tid >> 6), lane = tid & 63, wr = wid >> 2, wc = wid & 3, fr = lane & 15, fq = lane >> 4;
    const int K = g.K, nt = K / BK;
    unsigned voffA[2], voffB[2];
#pragma unroll
    for (int i = 0; i < 2; ++i) { int R, C; stage_rc(tid * 16 + i * 8192, R, C); const int Rb = Epi::PERM ? ((R & ~31) + perm32(R & 31)) : R;
        voffA[i] = (unsigned)(R * K + C) * 2u; voffB[i] = (unsigned)(Rb * K + C) * 2u; }
    const size_t kstep = (size_t)(BK * 2);
    const size_t hstep = (size_t)HALF * K * 2;
    const size_t tstep = 2 * hstep;
    const unsigned ldsw = (unsigned)wid * 1024u;
    const int aoff = lds_byte(wr * 64 + fr, fq * 8), boff = lds_byte(wc * 32 + fr, fq * 8);
#define PG8_SA(b, h) (((b) * 2 + (h)) * HTB)
#define PG8_SB(b, h) ((4 + (b) * 2 + (h)) * HTB)
#define PG8_STAGE(bufoff, gbase, voff) do { _Pragma("unroll") for (int _i = 0; _i < 2; ++_i) \
        __builtin_amdgcn_global_load_lds((const unsigned*)((const char*)(gbase) + (voff)[_i]), (PG8_LAS unsigned*)(lds + (bufoff) + ldsw + _i * 8192), 16, 0, 0); } while (0)
#define PG8_LDA(dst, b, h) do { _Pragma("unroll") for (int m = 0; m < 4; ++m) _Pragma("unroll") for (int k = 0; k < 2; ++k) dst[m][k] = *(const PG8_LAS bf16x8*)(lds + PG8_SA(b, h) + aoff + m * 2048 + k * 1024); } while (0)
#define PG8_LDB(dst, b, h) do { _Pragma("unroll") for (int n = 0; n < 2; ++n) _Pragma("unroll") for (int k = 0; k < 2; ++k) dst[n][k] = *(const PG8_LAS bf16x8*)(lds + PG8_SB(b, h) + boff + n * 2048 + k * 1024); } while (0)
#define PG8_MMA(ai, bj, At, Bt) do { __builtin_amdgcn_s_setprio(1); _Pragma("unroll") for (int m = 0; m < 4; ++m) _Pragma("unroll") for (int n = 0; n < 2; ++n) _Pragma("unroll") for (int k = 0; k < 2; ++k) \
        acc[ai][bj][m][n] = __builtin_amdgcn_mfma_f32_16x16x32_bf16(Bt[n][k], At[m][k], acc[ai][bj][m][n], 0, 0, 0); __builtin_amdgcn_s_setprio(0); } while (0)
#define PG8_WAIT_V(n) asm volatile("s_waitcnt vmcnt(" #n ")" ::: "memory")
#define PG8_WAIT_L(n) asm volatile("s_waitcnt lgkmcnt(" #n ")" ::: "memory")
#define PG8_BAR __builtin_amdgcn_s_barrier()
#define PG8_SCHED __builtin_amdgcn_sched_barrier(0)
    Unit cur, nxt; int ui = 0;
    if (!S.next(0, cur)) return;
    f32x4 acc[2][2][4][2];
#pragma unroll
    for (int a = 0; a < 2; ++a)
#pragma unroll
        for (int b = 0; b < 2; ++b)
#pragma unroll
            for (int m = 0; m < 4; ++m)
#pragma unroll
                for (int n = 0; n < 2; ++n) acc[a][b][m][n] = (f32x4){0.f, 0.f, 0.f, 0.f};
    bf16x8 At[4][2], B0[2][2], B1[2][2];
    const char* cA = (const char*)g.A + (size_t)cur.pm * tstep; const char* cB = (const char*)g.Bt + (size_t)cur.pn * tstep;
    S.a_ready(cur);
    if constexpr (SP2) {
        PG8_STAGE(PG8_SB(0, 0), cB, voffB); PG8_STAGE(PG8_SB(0, 1), cB + hstep, voffB); PG8_STAGE(PG8_SA(0, 0), cA, voffA); PG8_STAGE(PG8_SA(0, 1), cA + hstep, voffA);
        if (wr == 1) PG8_BAR;
        PG8_WAIT_V(2); PG8_BAR;
        PG8_STAGE(PG8_SB(1, 0), cB + kstep, voffB); PG8_STAGE(PG8_SA(1, 0), cA + kstep, voffA); PG8_STAGE(PG8_SB(1, 1), cB + hstep + kstep, voffB);
        PG8_WAIT_V(6); PG8_BAR;
    } else {
        PG8_STAGE(PG8_SB(0, 0), cB, voffB); PG8_STAGE(PG8_SA(0, 0), cA, voffA); PG8_STAGE(PG8_SB(0, 1), cB + hstep, voffB); PG8_STAGE(PG8_SA(0, 1), cA + hstep, voffA);
        if (wr == 1) PG8_BAR;
        PG8_WAIT_V(4); PG8_BAR;
        PG8_STAGE(PG8_SB(1, 0), cB + kstep, voffB); PG8_STAGE(PG8_SA(1, 0), cA + kstep, voffA); PG8_STAGE(PG8_SB(1, 1), cB + hstep + kstep, voffB);
        PG8_WAIT_V(6); PG8_BAR;
    }
    for (;;) {
        const bool has_next = S.next(ui + 1, nxt);
        const char* nA = has_next ? (const char*)g.A + (size_t)nxt.pm * tstep : cA; const char* nB = has_next ? (const char*)g.Bt + (size_t)nxt.pn * tstep : cB;
        for (int t = 0; t < nt; t += 2) {
            const bool last = (t == nt - 2);
            const char* a1 = cA + (size_t)(t + 1) * kstep;
            const char* a2 = last ? nA : cA + (size_t)(t + 2) * kstep; const char* b2 = last ? nB : cB + (size_t)(t + 2) * kstep;
            const char* a3 = a2 + kstep; const char* b3 = b2 + kstep;
            if (last && has_next) S.a_ready(nxt);
            if constexpr (SP2) {
            PG8_LDB(B0, 0, 0); PG8_LDB(B1, 0, 1); PG8_SCHED; PG8_LDA(At, 0, 0); PG8_STAGE(PG8_SA(1, 1), a1 + hstep, voffA);
            PG8_WAIT_V(8); PG8_WAIT_L(0); PG8_BAR; PG8_MMA(0, 0, At, B0); PG8_MMA(0, 1, At, B1); PG8_BAR; PG8_SCHED;
            PG8_LDA(At, 0, 1); PG8_STAGE(PG8_SB(0, 0), b2, voffB); PG8_STAGE(PG8_SB(0, 1), b2 + hstep, voffB); PG8_STAGE(PG8_SA(0, 0), a2, voffA);
            PG8_WAIT_V(8); PG8_WAIT_L(0); PG8_BAR; PG8_MMA(1, 0, At, B0); PG8_MMA(1, 1, At, B1); PG8_BAR; PG8_SCHED;
            PG8_LDB(B0, 1, 0); PG8_LDB(B1, 1, 1); PG8_SCHED; PG8_LDA(At, 1, 0); PG8_STAGE(PG8_SA(0, 1), a2 + hstep, voffA);
            PG8_WAIT_V(8); PG8_WAIT_L(0); PG8_BAR; PG8_MMA(0, 0, At, B0); PG8_MMA(0, 1, At, B1); PG8_BAR; PG8_SCHED;
            PG8_LDA(At, 1, 1); PG8_STAGE(PG8_SB(1, 0), b3, voffB); PG8_STAGE(PG8_SB(1, 1), b3 + hstep, voffB); PG8_STAGE(PG8_SA(1, 0), a3, voffA);
            PG8_WAIT_V(8); PG8_WAIT_L(0); PG8_BAR; PG8_MMA(1, 0, At, B0); PG8_MMA(1, 1, At, B1); PG8_BAR; PG8_SCHED;
            } else {
            PG8_LDB(B0, 0, 0); PG8_SCHED; PG8_LDA(At, 0, 0); PG8_STAGE(PG8_SA(1, 1), a1 + hstep, voffA);
            PG8_WAIT_L(8); PG8_BAR; PG8_WAIT_L(0); PG8_MMA(0, 0, At, B0); PG8_BAR; PG8_SCHED;
            PG8_LDB(B1, 0, 1); PG8_STAGE(PG8_SB(0, 0), b2, voffB);
            PG8_BAR; PG8_WAIT_L(0); PG8_MMA(0, 1, At, B1); PG8_BAR;
            PG8_LDA(At, 0, 1); PG8_STAGE(PG8_SA(0, 0), a2, voffA);
            PG8_BAR; PG8_WAIT_L(0); PG8_MMA(1, 0, At, B0); PG8_BAR; PG8_SCHED;
            PG8_STAGE(PG8_SB(0, 1), b2 + hstep, voffB);
            PG8_WAIT_V(6); PG8_BAR; PG8_MMA(1, 1, At, B1); PG8_BAR;
            PG8_LDB(B0, 1, 0); PG8_SCHED; PG8_LDA(At, 1, 0); PG8_STAGE(PG8_SA(0, 1), a2 + hstep, voffA);
            PG8_WAIT_L(8); PG8_BAR; PG8_WAIT_L(0); PG8_MMA(0, 0, At, B0); PG8_BAR; PG8_SCHED;
            PG8_LDB(B1, 1, 1); PG8_STAGE(PG8_SB(1, 0), b3, voffB);
            PG8_BAR; PG8_WAIT_L(0); PG8_MMA(0, 1, At, B1); PG8_BAR;
            PG8_LDA(At, 1, 1); PG8_STAGE(PG8_SA(1, 0), a3, voffA);
            PG8_BAR; PG8_WAIT_L(0); PG8_MMA(1, 0, At, B0); PG8_BAR; PG8_SCHED;
            PG8_STAGE(PG8_SB(1, 1), b3 + hstep, voffB);
            PG8_WAIT_V(6); PG8_BAR; PG8_MMA(1, 1, At, B1); PG8_BAR;
            }
        }
        if constexpr (ALIGN_EPI) { if (wr == 0) PG8_BAR; }
        if constexpr (!Epi::AFTER_DRAIN) { E(acc, cur, wr, wc, fr, fq); S.done(cur); }
        if (!has_next) break;
#pragma unroll
        for (int a = 0; a < 2; ++a)
#pragma unroll
            for (int b = 0; b < 2; ++b)
#pragma unroll
                for (int m = 0; m < 4; ++m)
#pragma unroll
                    for (int n = 0; n < 2; ++n) acc[a][b][m][n] = (f32x4){0.f, 0.f, 0.f, 0.f};
        cur = nxt; cA = nA; cB = nB; ++ui;
        if constexpr (ALIGN_EPI) { if (wr == 1) PG8_BAR; }
    }
    PG8_WAIT_V(0);
    if constexpr (!ALIGN_EPI) { if (wr == 0) PG8_BAR; }
    PG8_BAR;
    if constexpr (Epi::AFTER_DRAIN) { E.fused(acc, cur, wr, wc, fr, fq, lds, wid, lane); S.done(cur); }
#undef PG8_SA
#undef PG8_SB
#undef PG8_STAGE
#undef PG8_LDA
#undef PG8_LDB
#undef PG8_MMA
#undef PG8_WAIT_V
#undef PG8_WAIT_L
#undef PG8_BAR
#undef PG8_SCHED
}
}
namespace att {
#define ATT_LAS __attribute__((address_space(3)))
typedef unsigned short bf16_t;
typedef short bf16x8 __attribute__((ext_vector_type(8)));
typedef short s16x4 __attribute__((ext_vector_type(4)));
typedef float f32x16 __attribute__((ext_vector_type(16)));
typedef unsigned u32x4 __attribute__((ext_vector_type(4)));
typedef unsigned u32x2 __attribute__((ext_vector_type(2)));
constexpr int QKV_LD = 2304, O_LD = 1024, SEQ = 2048, CHUNK = 64;
constexpr int BT_STRIDE = 324;
constexpr int KROW = 144, KTILE = 64 * KROW, VTILE = 8192, LDS_V = 4 * KTILE, LDS_BT = LDS_V + 4 * VTILE, LDS_END = LDS_BT + 8 * BT_STRIDE * 4;
constexpr float THR = 8.0f;
__device__ __forceinline__ int crow(int r, int hi) { return (r & 3) + 8 * (r >> 2) + 4 * hi; }
__device__ __forceinline__ unsigned cvtpk(float lo, float hi) { unsigned r; asm volatile("v_cvt_pk_bf16_f32 %0, %1, %2" : "=v"(r) : "v"(lo), "v"(hi)); return r; }
__device__ __forceinline__ s16x4 vtr(const ATT_LAS unsigned char* p) { return __builtin_bit_cast(s16x4, __builtin_amdgcn_ds_read_tr16_b64_v4i16((ATT_LAS s16x4*)p)); }

template <int KIND>
__device__ __forceinline__ void attn_round(const bf16_t* __restrict__ QKV, bf16_t* __restrict__ O, int b, int c, int g, ATT_LAS unsigned char* lds, const float* sinks, int tid) {
    constexpr int L = KIND == 0 ? 8 : 2, NH = KIND == 0 ? 4 : 1;
    const int lane = tid & 63, wave = tid >> 6, r32 = lane & 31, hi = lane >> 5;
    const int h = 4 * g + (wave >> 1), qhalf = wave & 1, hs = KIND == 0 ? (wave >> 1) : 0;
    const int qcol = KIND == 0 ? h * 64 : 1536 + h * 64;
    const int ocol = KIND == 0 ? h * 64 : 512 + h * 64;
    const int kcol0 = KIND == 0 ? 512 + 256 * g : 2048 + 64 * g;
    const int vcol0 = KIND == 0 ? 1024 + 256 * g : 2176 + 64 * g;
    const long tok0 = (long)b * SEQ + c * CHUNK;
    const int j0 = (L - c) > 0 ? (L - c) : 0;
    const int lrow = tid >> 3, lch = tid & 7;
    const bf16_t* kg = QKV + (size_t)(tok0 - L * CHUNK + lrow) * QKV_LD + kcol0 + 8 * lch;
    const bf16_t* vg = QKV + (size_t)(tok0 - L * CHUNK + lrow) * QKV_LD + vcol0 + 8 * lch;
    const int kw = lrow * KROW + lch * 16;
    const int vw = LDS_V + (lch >> 2) * 4096 + (lrow >> 4) * 1024 + ((lrow >> 3) & 1) * 512 + (lrow & 7) * 64 + (lch & 3) * 16;
    u32x4 kr[NH], vr[NH];
#pragma unroll
    for (int i = 0; i < NH; ++i) { kr[i] = *(const u32x4*)(kg + (size_t)(j0 * 64) * QKV_LD + 64 * i); vr[i] = *(const u32x4*)(vg + (size_t)(j0 * 64) * QKV_LD + 64 * i); }
    bf16x8 qr[4];
    { const bf16_t* qp = QKV + (size_t)(tok0 + qhalf * 32 + r32) * QKV_LD + qcol + 8 * hi;
#pragma unroll
      for (int d0 = 0; d0 < 4; ++d0) qr[d0] = *(const bf16x8*)(qp + 16 * d0); }
    const ATT_LAS unsigned char* kl = lds + hs * KTILE + r32 * KROW + 16 * hi;
    const ATT_LAS unsigned char* vl = lds + LDS_V + hs * VTILE + (4 * hi + ((lane & 15) >> 2)) * 64 + ((lane >> 4) & 1) * 32 + (lane & 3) * 8;
    const ATT_LAS float* bt = (const ATT_LAS float*)(lds + LDS_BT) + h * BT_STRIDE;
    float m = KIND == 0 ? 0.0f : sinks[h] * 1.4426950408889634f, l = (KIND == 1 && hi == 0) ? 1.0f : 0.0f;
    f32x16 o[2]; o[0] = f32x16{}; o[1] = f32x16{};
    const float cb = KIND == 0 ? bt[256] : 0.f;
    f32x16 csp;
#pragma unroll
    for (int r = 0; r < 16; ++r) csp[r] = cb - m;
    const int iq = qhalf * 32 + r32;
    for (int j = j0; j <= L; ++j) {
        __syncthreads();
#pragma unroll
        for (int i = 0; i < NH; ++i) { *(ATT_LAS u32x4*)(lds + i * KTILE + kw) = kr[i]; *(ATT_LAS u32x4*)(lds + i * VTILE + vw) = vr[i]; }
        __syncthreads();
        if (j < L) {
#pragma unroll
            for (int i = 0; i < NH; ++i) { kr[i] = *(const u32x4*)(kg + (size_t)((j + 1) * 64) * QKV_LD + 64 * i); vr[i] = *(const u32x4*)(vg + (size_t)((j + 1) * 64) * QKV_LD + 64 * i); }
        }
        f32x16 p[2];
        if (KIND == 0 && j >= 6) {
            const ATT_LAS float* btl = bt + (640 + iq - 4 * hi - 64 * j);
#pragma unroll
            for (int kb = 0; kb < 2; ++kb)
#pragma unroll
                for (int r = 0; r < 16; ++r) p[kb][r] = btl[-(32 * kb + (r & 3) + 8 * (r >> 2))] - m;
#pragma unroll
            for (int kb = 0; kb < 2; ++kb)
#pragma unroll
                for (int d0 = 0; d0 < 4; ++d0) { const bf16x8 kf = *(const ATT_LAS bf16x8*)(kl + kb * 32 * KROW + d0 * 32); p[kb] = __builtin_amdgcn_mfma_f32_32x32x16_bf16(kf, qr[d0], p[kb], 0, 0, 0); }
        } else {
#pragma unroll
            for (int kb = 0; kb < 2; ++kb)
#pragma unroll
                for (int d0 = 0; d0 < 4; ++d0) { const bf16x8 kf = *(const ATT_LAS bf16x8*)(kl + kb * 32 * KROW + d0 * 32);
                    if (d0 == 0) p[kb] = __builtin_amdgcn_mfma_f32_32x32x16_bf16(kf, qr[d0], csp, 0, 0, 0); else p[kb] = __builtin_amdgcn_mfma_f32_32x32x16_bf16(kf, qr[d0], p[kb], 0, 0, 0); }
        }
        float mx = fmaxf(fmaxf(p[0][0], p[0][1]), p[1][0]);
#pragma unroll
        for (int r = 2; r < 16; r += 2) mx = fmaxf(fmaxf(mx, p[0][r]), p[0][r + 1]);
#pragma unroll
        for (int r = 1; r < 16; r += 2) mx = fmaxf(fmaxf(mx, p[1][r]), p[1][(r + 1) & 15]);
        mx = fmaxf(mx, __shfl_xor(mx, 32));
        if (KIND == 0 && j == j0) {
            m = mx;
#pragma unroll
            for (int r = 0; r < 16; ++r) { p[0][r] -= mx; p[1][r] -= mx; csp[r] = cb - m; }
        } else if (__any(mx > THR)) {
            const float dl = fmaxf(mx, 0.f), f = __builtin_amdgcn_exp2f(-dl); m += dl; l *= f;
#pragma unroll
            for (int r = 0; r < 16; ++r) { o[0][r] *= f; o[1][r] *= f; p[0][r] -= dl; p[1][r] -= dl; csp[r] = cb - m; }
        }
        float ls0 = 0.f, ls1 = 0.f;
#pragma unroll
        for (int r = 0; r < 16; ++r) { p[0][r] = __builtin_amdgcn_exp2f(p[0][r]); p[1][r] = __builtin_amdgcn_exp2f(p[1][r]); ls0 += p[0][r]; ls1 += p[1][r]; }
        l += ls0 + ls1;
#pragma unroll
        for (int ks = 0; ks < 4; ++ks) { const int kb = ks >> 1, s = ks & 1;
            u32x4 pw; pw.x = cvtpk(p[kb][8 * s + 0], p[kb][8 * s + 1]); pw.y = cvtpk(p[kb][8 * s + 2], p[kb][8 * s + 3]); pw.z = cvtpk(p[kb][8 * s + 4], p[kb][8 * s + 5]); pw.w = cvtpk(p[kb][8 * s + 6], p[kb][8 * s + 7]);
            const bf16x8 pa = __builtin_bit_cast(bf16x8, pw);
#pragma unroll
            for (int d0 = 0; d0 < 2; ++d0) { const s16x4 lo = vtr(vl + d0 * 4096 + ks * 1024), hh = vtr(vl + d0 * 4096 + ks * 1024 + 512);
                const bf16x8 vf = (bf16x8){lo[0], lo[1], lo[2], lo[3], hh[0], hh[1], hh[2], hh[3]};
                o[d0] = __builtin_amdgcn_mfma_f32_32x32x16_bf16(vf, pa, o[d0], 0, 0, 0); } }
    }
    l += __shfl_xor(l, 32);
    const float inv = 1.0f / l;
    bf16_t* op = O + (size_t)(tok0 + qhalf * 32 + r32) * O_LD + ocol + 4 * hi;
#pragma unroll
    for (int d0 = 0; d0 < 2; ++d0)
#pragma unroll
        for (int gq = 0; gq < 4; ++gq) { u32x2 w; w.x = cvtpk(o[d0][4 * gq] * inv, o[d0][4 * gq + 1] * inv); w.y = cvtpk(o[d0][4 * gq + 2] * inv, o[d0][4 * gq + 3] * inv);
            *(u32x2*)(op + 32 * d0 + 8 * gq) = w; }
}
}
constexpr int NWAVES = 8;
#ifndef MK_PER_PHASE
#define MK_PER_PHASE 0
#endif
constexpr int NPHASE = 11;
constexpr int BATCH = 32, SEQ = 2048, D = 1024, FF = 2816, DIN = 2304, M = BATCH * SEQ;
constexpr float EPS = 1e-6f;
constexpr size_t MiB = 1u << 20;
constexpr size_t WS_W1GU = 2 * MiB, WS_W1D = 14 * MiB, WS_WIN = 20 * MiB, WS_WOUT = 25 * MiB, WS_W2GU = 28 * MiB, WS_W2D = 40 * MiB, WS_ROPE = 46 * MiB, WS_RPART = 50 * MiB;
constexpr size_t WS_XN = 64 * MiB;
constexpr size_t WS_ACT = 192 * MiB;
constexpr size_t WS_F = 544 * MiB;
constexpr size_t WS_H = 672 * MiB;
constexpr size_t WS_ROWR = 56 * MiB;
constexpr size_t WS_END = 800 * MiB;
constexpr int LDS_BYTES = 147456;
constexpr size_t WS_CTL = 0, CTL_ZERO_BYTES = 65536;
constexpr int CW_BAR = 4096, CW_XCNT = 8192, CW_XLB = 10240;

#define LAS __attribute__((address_space(3)))
typedef unsigned short bf16;
typedef unsigned v4u __attribute__((ext_vector_type(4)));
typedef unsigned v2u __attribute__((ext_vector_type(2)));
typedef float f32x4 __attribute__((ext_vector_type(4)));
__device__ __forceinline__ unsigned pk2(float lo, float hi) { return pg8::cvt_pk_bf16(lo, hi); }
__device__ __forceinline__ float bf2f(unsigned short v) { return __uint_as_float((unsigned)v << 16); }
template <int CTRL> __device__ __forceinline__ float dpp_add(float v) { return v + __int_as_float(__builtin_amdgcn_update_dpp(0, __float_as_int(v), CTRL, 0xF, 0xF, true)); }
__device__ __forceinline__ float wave_sum(float v) {
    v = dpp_add<0xB1>(v); v = dpp_add<0x4E>(v); v = dpp_add<0x141>(v); v = dpp_add<0x140>(v);
    { auto rr = __builtin_amdgcn_permlane16_swap(__float_as_uint(v), __float_as_uint(v), false, false); v = __uint_as_float(rr[0]) + __uint_as_float(rr[1]); }
    { auto rr = __builtin_amdgcn_permlane32_swap(__float_as_uint(v), __float_as_uint(v), false, false); v = __uint_as_float(rr[0]) + __uint_as_float(rr[1]); }
    return v;
}
__device__ __forceinline__ void p0_transpose_item(const float* W, int K, int N, bf16* WT, int mode, LAS float* scr, int item, int lane) {
    const int nblk = N / 32, kb = item / nblk, nb = item % nblk, k0 = 64 * kb, n0 = 32 * nb;
    const int drow0 = mode == 0 ? n0 : ((n0 >> 7) * 256 + (n0 & 127) + (mode == 2 ? 128 : 0));
#pragma unroll 8
    for (int i = 0; i < 32; ++i) { const int kk = 2 * i + (lane >> 5); scr[kk * 33 + (lane & 31)] = W[(size_t)(k0 + kk) * N + n0 + (lane & 31)]; }
    asm volatile("s_waitcnt lgkmcnt(0)" ::: "memory");
    const int c = lane & 7;
#pragma unroll
    for (int j = 0; j < 4; ++j) { const int n = (lane >> 3) + 8 * j; const LAS float* s = scr + (8 * c) * 33 + n;
        v4u o; o.x = pk2(s[0 * 33], s[1 * 33]); o.y = pk2(s[2 * 33], s[3 * 33]); o.z = pk2(s[4 * 33], s[5 * 33]); o.w = pk2(s[6 * 33], s[7 * 33]);
        *(v4u*)(WT + (size_t)(drow0 + n) * K + k0 + 8 * c) = o; }
    asm volatile("s_waitcnt lgkmcnt(0)" ::: "memory");
}
#define XB_TMO      128
#define XB_XCNT(j)  (256  + 64 * (j))
#define XB_XSUB(j)  (1280 + 64 * (j))
#define XB_XGEN(j)  (2304 + 64 * (j))
#define XB_TOP      3328
#define XB_TOPGEN   3392
#define XCD_BAR_WORDS 3456
#define XB_SPIN_CAP (1u << 18)

__device__ __forceinline__ unsigned xb_ld(unsigned* p)              { return __hip_atomic_load(p, __ATOMIC_RELAXED, __HIP_MEMORY_SCOPE_AGENT); }
__device__ __forceinline__ unsigned xb_add(unsigned* p, unsigned v) { return __hip_atomic_fetch_add(p, v, __ATOMIC_RELAXED, __HIP_MEMORY_SCOPE_AGENT); }
__device__ __forceinline__ unsigned xb_xcc_id() { return (unsigned)__builtin_amdgcn_s_getreg((3 << 11) | 20) & 0xFu; }
#define XB_SPIN(cond, bar) do { unsigned _sp = 0; while (cond) { __builtin_amdgcn_s_sleep(1); \
    if ((++_sp & 255u) == 0u) { if (xb_ld(&(bar)[XB_TMO])) break; if (_sp > XB_SPIN_CAP) { atomicAdd(&(bar)[XB_TMO], 1u); break; } } } } while (0)

struct XcdBarrier {
    unsigned* bar; unsigned x;
    volatile LAS unsigned* st;
};

__device__ __forceinline__ XcdBarrier xcd_barrier_post(unsigned* bar, volatile LAS unsigned* st) {
    XcdBarrier b; b.bar = bar; b.x = xb_xcc_id(); b.st = st;
    if (threadIdx.x == 0) (void)xb_add(&bar[XB_XCNT(b.x)], 1u);
    return b;
}
__device__ __forceinline__ void xcd_barrier_complete(unsigned* bar, unsigned x, unsigned& nloc, unsigned& nx) {
    const unsigned G = gridDim.x * gridDim.y * gridDim.z;
    unsigned sum, cnt, mine, sp = 0u;
    for (;;) {
        sum = 0u; cnt = 0u; mine = 0u;
#pragma unroll
        for (unsigned j = 0; j < 16; ++j) { const unsigned c = xb_ld(&bar[XB_XCNT(j)]); sum += c; cnt += (c > 0u) ? 1u : 0u; mine = (j == x) ? c : mine; }
        if (sum == G) break;
        __builtin_amdgcn_s_sleep(1);
        if ((++sp & 255u) == 0u) { if (xb_ld(&bar[XB_TMO])) break; if (sp > XB_SPIN_CAP) { atomicAdd(&bar[XB_TMO], 1u); break; } }
    }
    nloc = mine > 0u ? mine : 1u; nx = cnt > 0u ? cnt : 1u;
}

__device__ __forceinline__ void xcd_barrier(const XcdBarrier& b) {
    asm volatile("s_waitcnt vmcnt(0)" ::: "memory");
    __syncthreads();
    if (threadIdx.x == 0) {
        unsigned* bar = b.bar;
        __builtin_amdgcn_s_waitcnt(0);
        unsigned nloc = b.st[0], nx = b.st[1];
        if (nloc == 0u) { xcd_barrier_complete(bar, b.x, nloc, nx); b.st[0] = nloc; b.st[1] = nx; }
        const unsigned old = xb_add(&bar[XB_XSUB(b.x)], 1u);
        const unsigned gen = old / nloc;
        if (old + 1u == (gen + 1u) * nloc) {
            __builtin_amdgcn_fence(__ATOMIC_RELEASE, "agent");
            asm volatile("s_waitcnt vmcnt(0)" ::: "memory");
            const unsigned og = xb_add(&bar[XB_TOP], 1u);
            const unsigned tg = og / nx;
            if (og + 1u == (tg + 1u) * nx) xb_add(&bar[XB_TOPGEN], 1u);
            else XB_SPIN(xb_ld(&bar[XB_TOPGEN]) == tg, bar);
            __builtin_amdgcn_fence(__ATOMIC_ACQUIRE, "agent");
            xb_add(&bar[XB_XGEN(b.x)], 1u);
            asm volatile("s_waitcnt vmcnt(0)" ::: "memory");
        } else {
            XB_SPIN(xb_ld(&bar[XB_XGEN(b.x)]) == gen, bar);
            __builtin_amdgcn_fence(__ATOMIC_ACQUIRE, "agent");
            asm volatile("s_waitcnt vmcnt(0)" ::: "memory");
        }
    }
    __syncthreads();
}

__device__ __forceinline__ void xcd_local_barrier(unsigned* cnt, unsigned target) {
    asm volatile("s_waitcnt vmcnt(0)" ::: "memory");
    __syncthreads();
    if (threadIdx.x == 0) {
        __builtin_amdgcn_s_waitcnt(0);
        (void)__hip_atomic_fetch_add(cnt, 1u, __ATOMIC_RELAXED, __HIP_MEMORY_SCOPE_AGENT);
        unsigned sp = 0;
        while (xb_ld(cnt) < target) { __builtin_amdgcn_s_sleep(1); if (++sp > XB_SPIN_CAP) break; }
        __builtin_amdgcn_fence(__ATOMIC_ACQUIRE, "agent");
        asm volatile("s_waitcnt vmcnt(0)" ::: "memory");
    }
    __syncthreads();
}

struct Args {
    const float* x; const int* pos; const float* g_pre1; const float* w1g; const float* w1u; const float* w1d; const float* g_post1; const float* g_mpre; const float* w_in; const float* relb;
    const float* sinks; const float* w_out; const float* g_mpost; const float* g_pre2; const float* w2g; const float* w2u; const float* w2d; const float* g_post2; const float* g_fin;
    float* out; unsigned char* ws; float invf[8]; int ph_lo, ph_hi;
};
__device__ __forceinline__ void rms_row_to_bf16(const float* xrow, const float* g, bf16* orow, int lane) {
    const f32x4* xr = (const f32x4*)xrow + lane; const f32x4* gr = (const f32x4*)g + lane;
    f32x4 v[4]; float s = 0.f;
#pragma unroll
    for (int j = 0; j < 4; ++j) { v[j] = xr[64 * j]; s += (v[j].x * v[j].x + v[j].y * v[j].y) + (v[j].z * v[j].z + v[j].w * v[j].w); }
    const float r = 1.0f / sqrtf(wave_sum(s) * (1.f / D) + EPS);
    v2u* o8 = (v2u*)orow + lane;
#pragma unroll
    for (int j = 0; j < 4; ++j) { const f32x4 gg = gr[64 * j]; v2u w; w.x = pk2(v[j].x * r * gg.x, v[j].y * r * gg.y); w.y = pk2(v[j].z * r * gg.z, v[j].w * r * gg.w); o8[64 * j] = w; }
}
__device__ __forceinline__ f32x4 ld_bf4(const bf16* p) { const v2u w = *(const v2u*)p; f32x4 r; r.x = __uint_as_float(w.x << 16); r.y = __uint_as_float(w.x & 0xffff0000u); r.z = __uint_as_float(w.y << 16); r.w = __uint_as_float(w.y & 0xffff0000u); return r; }
__device__ __forceinline__ void st_bf4(bf16* p, f32x4 v) { v2u w; w.x = pk2(v.x, v.y); w.y = pk2(v.z, v.w); *(v2u*)p = w; }
template <bool BF32, int R> struct RowBuf { f32x4 bf[BF32 ? R : 1][4]; v2u bh[BF32 ? 1 : R][4]; v2u f[R][4]; float ss[R], rp[R]; };
template <bool BF32, int R>
__device__ __forceinline__ void fix_load(RowBuf<BF32, R>& B, int row0, const float* basef, const bf16* F, const float* rpart, const float* rowr, const bf16* xn, int lane) {
#pragma unroll
    for (int r = 0; r < R; ++r) { const size_t ro = (size_t)(row0 + r) * D + 4 * lane;
        B.ss[r] = lane < 16 ? rpart[(size_t)(row0 + r) * 16 + lane] : 0.f; B.rp[r] = BF32 ? 1.f : rowr[row0 + r];
#pragma unroll
        for (int j = 0; j < 4; ++j) { if (BF32) B.bf[r][j] = *(const f32x4*)(basef + ro + 256 * j); else B.bh[r][j] = *(const v2u*)(xn + ro + 256 * j); B.f[r][j] = *(const v2u*)(F + ro + 256 * j); } }
}
__device__ __forceinline__ f32x4 cv_bf4(v2u w) { f32x4 r; r.x = __uint_as_float(w.x << 16); r.y = __uint_as_float(w.x & 0xffff0000u); r.z = __uint_as_float(w.y << 16); r.w = __uint_as_float(w.y & 0xffff0000u); return r; }
template <int MODE, bool BF32, int R>
__device__ __forceinline__ void fix_compute(RowBuf<BF32, R>& B, int row0, float coef, const f32x4 (&gp)[4], const f32x4 (&gi)[4], const f32x4 (&gn)[4], float* rowr, bf16* xn, float* outf, int lane) {
#pragma unroll
    for (int r = 0; r < R; ++r) { const size_t ro = (size_t)(row0 + r) * D + 4 * lane;
        const float rf = coef / sqrtf(wave_sum(B.ss[r]) * (1.f / D) + EPS), rpi = BF32 ? 1.f : 1.0f / B.rp[r]; float s = 0.f; f32x4 h[4];
#pragma unroll
        for (int j = 0; j < 4; ++j) { const f32x4 bs = BF32 ? B.bf[r][j] : (cv_bf4(B.bh[r][j]) * rpi) * gi[j]; h[j] = bs + (cv_bf4(B.f[r][j]) * rf) * gp[j]; s += (h[j].x * h[j].x + h[j].y * h[j].y) + (h[j].z * h[j].z + h[j].w * h[j].w); }
        const float rh = 1.0f / sqrtf(wave_sum(s) * (1.f / D) + EPS);
        if (MODE == 0 && lane == 0) rowr[row0 + r] = rh;
#pragma unroll
        for (int j = 0; j < 4; ++j) { const f32x4 o = (h[j] * rh) * gn[j];
            if (MODE == 0) { st_bf4(xn + ro + 256 * j, o); } else { *(f32x4*)(outf + ro + 256 * j) = o; } } }
}
template <int MODE, bool BF32>
__device__ __forceinline__ void fix_phase(int gw, int NGW, int rb, int re, const float* basef, const bf16* F, const float* rpart, float coef, const float* gpost, const float* gprev, const float* gnext, float* rowr, bf16* xn, float* outf, int lane) {
    constexpr int R = 2;
    f32x4 gp[4], gi[4], gn[4];
#pragma unroll
    for (int j = 0; j < 4; ++j) { gp[j] = *(const f32x4*)(gpost + 4 * lane + 256 * j); gn[j] = *(const f32x4*)(gnext + 4 * lane + 256 * j);
        if (!BF32) { const f32x4 gv = *(const f32x4*)(gprev + 4 * lane + 256 * j); gi[j] = (f32x4){1.0f / gv.x, 1.0f / gv.y, 1.0f / gv.z, 1.0f / gv.w}; } else gi[j] = (f32x4){1.f, 1.f, 1.f, 1.f}; }
    const int step = NGW * R; int m = rb + gw * R;
    RowBuf<BF32, R> A, B;
    if (m < re) fix_load<BF32, R>(A, m, basef, F, rpart, rowr, xn, lane);
    for (; m < re; m += 2 * step) {
        if (m + step < re) fix_load<BF32, R>(B, m + step, basef, F, rpart, rowr, xn, lane);
        fix_compute<MODE, BF32, R>(A, m, coef, gp, gi, gn, rowr, xn, outf, lane);
        if (m + step < re) { if (m + 2 * step < re) fix_load<BF32, R>(A, m + 2 * step, basef, F, rpart, rowr, xn, lane);
            fix_compute<MODE, BF32, R>(B, m + step, coef, gp, gi, gn, rowr, xn, outf, lane); }
    }
}
__device__ __forceinline__ void p0_rows(int gw, int NGW, const float* x, const float* g, bf16* XN, int lane) {
    f32x4 gg[4];
#pragma unroll
    for (int j = 0; j < 4; ++j) gg[j] = *(const f32x4*)(g + 4 * lane + 256 * j);
    constexpr int R = 2; const int step = NGW * R; int m = gw * R;
    f32x4 A[R][4], B[R][4];
#define P0_LOAD(buf, mm) do { _Pragma("unroll") for (int r = 0; r < R; ++r) _Pragma("unroll") for (int j = 0; j < 4; ++j) buf[r][j] = *(const f32x4*)(x + (size_t)((mm) + r) * D + 4 * lane + 256 * j); } while (0)
#define P0_DO(buf, mm) do { _Pragma("unroll") for (int r = 0; r < R; ++r) { float s = 0.f; \
        _Pragma("unroll") for (int j = 0; j < 4; ++j) s += (buf[r][j].x * buf[r][j].x + buf[r][j].y * buf[r][j].y) + (buf[r][j].z * buf[r][j].z + buf[r][j].w * buf[r][j].w); \
        const float rr = 1.0f / sqrtf(wave_sum(s) * (1.f / D) + EPS); \
        _Pragma("unroll") for (int j = 0; j < 4; ++j) st_bf4(XN + (size_t)((mm) + r) * D + 4 * lane + 256 * j, (buf[r][j] * rr) * gg[j]); } } while (0)
    if (m < M) P0_LOAD(A, m);
    for (; m < M; m += 2 * step) {
        if (m + step < M) P0_LOAD(B, m + step);
        P0_DO(A, m);
        if (m + step < M) { if (m + 2 * step < M) P0_LOAD(A, m + 2 * step); P0_DO(B, m + step); }
    }
#undef P0_LOAD
#undef P0_DO
}

__global__ void __launch_bounds__(NWAVES * 64, 2) mk_fwd(Args a) {
    __builtin_assume(__builtin_amdgcn_workitem_id_y() == 0); __builtin_assume(__builtin_amdgcn_workitem_id_z() == 0);
    extern __shared__ __attribute__((aligned(16))) unsigned char lds_raw[];
    LAS unsigned char* lds = (LAS unsigned char*)lds_raw;
    const int tid = threadIdx.x, lane = tid & 63, wave = __builtin_amdgcn_readfirstlane(tid >> 6);
    const int G = gridDim.x, bx = blockIdx.x;
    int vcu = (G % 8 == 0) ? (bx % 8) * (G / 8) + bx / 8 : bx;
    int gw = vcu * NWAVES + wave; const int NGW = G * NWAVES;
    int cbx = bx, xloc = 0, xidx = 0, xrank = 0;
    unsigned lep = 0;
    unsigned char* ws = a.ws;
    bf16* W1GU = (bf16*)(ws + WS_W1GU); bf16* W1D = (bf16*)(ws + WS_W1D); bf16* WIN = (bf16*)(ws + WS_WIN); bf16* WOUT = (bf16*)(ws + WS_WOUT); bf16* W2GU = (bf16*)(ws + WS_W2GU); bf16* W2D = (bf16*)(ws + WS_W2D);
    float* ROPE = (float*)(ws + WS_ROPE); float* RPART = (float*)(ws + WS_RPART);
    bf16* XN = (bf16*)(ws + WS_XN); bf16* ACT = (bf16*)(ws + WS_ACT); bf16* QKV = (bf16*)(ws + WS_ACT); bf16* OB = (bf16*)(ws + WS_H); bf16* FB = (bf16*)(ws + WS_F);
    float* ROWR = (float*)(ws + WS_ROWR);
    const int lo = a.ph_lo, hi = a.ph_hi;
    volatile LAS unsigned* MISC = (volatile LAS unsigned*)(lds + LDS_BYTES - 64);
    if (tid < 16) MISC[tid] = 0u;
    __syncthreads();
    XcdBarrier bar = xcd_barrier_post((unsigned*)(ws + WS_CTL) + CW_BAR, MISC + 8);
    if (tid == 0) { const unsigned xcc = xb_xcc_id(); MISC[0] = xcc; MISC[1] = xb_add((unsigned*)(ws + WS_CTL) + CW_XCNT + 64 * xcc, 1u); }
#define IN(k) (lo <= (k) && (k) < hi)
    if (hi > 1000) cg::this_grid().sync();
#define SEAM(k) do { if (IN(k) && IN((k) + 1)) { xcd_barrier(bar); } } while (0)
#define LSEAM(k) do { if (IN(k) && IN((k) + 1)) { if (xloc) { ++lep; xcd_local_barrier((unsigned*)(ws + WS_CTL) + CW_XLB + 64 * xidx, lep * (unsigned)(G / 8)); } else xcd_barrier(bar); } } while (0)

    if (IN(0)) {
        LAS float* scr = (LAS float*)(lds + wave * 16384);
        constexpr int I_GU = (D / 64) * (FF / 32), I_DN = (FF / 64) * (D / 32), I_IN = (D / 64) * (DIN / 32), I_OUT = (D / 64) * (D / 32);
        constexpr int NITEMS = 4 * I_GU + 2 * I_DN + I_IN + I_OUT;
        for (int it = gw; it < NITEMS; it += NGW) {
            int r = it;
            if (r < I_GU) { p0_transpose_item(a.w1g, D, FF, W1GU, 1, scr, r, lane); continue; } r -= I_GU;
            if (r < I_GU) { p0_transpose_item(a.w1u, D, FF, W1GU, 2, scr, r, lane); continue; } r -= I_GU;
            if (r < I_GU) { p0_transpose_item(a.w2g, D, FF, W2GU, 1, scr, r, lane); continue; } r -= I_GU;
            if (r < I_GU) { p0_transpose_item(a.w2u, D, FF, W2GU, 2, scr, r, lane); continue; } r -= I_GU;
            if (r < I_DN) { p0_transpose_item(a.w1d, FF, D, W1D, 0, scr, r, lane); continue; } r -= I_DN;
            if (r < I_DN) { p0_transpose_item(a.w2d, FF, D, W2D, 0, scr, r, lane); continue; } r -= I_DN;
            if (r < I_IN) { p0_transpose_item(a.w_in, D, DIN, WIN, 0, scr, r, lane); continue; } r -= I_IN;
            p0_transpose_item(a.w_out, D, D, WOUT, 0, scr, r, lane);
        }
        for (int i = gw * 64 + lane; i < M * 8; i += NGW * 64) { const int tok = i >> 3, j = i & 7;
            const float ang = (float)a.pos[tok] * a.invf[j];
            const double rev = (double)ang * 0.15915494309189535; const float fr = (float)(rev - floor(rev));
            ROPE[(size_t)tok * 16 + j] = __builtin_amdgcn_cosf(fr); ROPE[(size_t)tok * 16 + 8 + j] = __builtin_amdgcn_sinf(fr); }
        p0_rows(gw, NGW, a.x, a.g_pre1, XN, lane);
    }
    SEAM(0);
    if (IN(0) && IN(1)) {
        if (tid == 0) { const unsigned xcc = MISC[0]; unsigned npop = 0, before = 0, ok = (G % 8 == 0) ? 1u : 0u;
            for (unsigned j = 0; j < 16; ++j) { const unsigned cj = xb_ld((unsigned*)(ws + WS_CTL) + CW_XCNT + 64 * j); if (cj) { ++npop; if (cj != (unsigned)(G / 8)) ok = 0u; if (j < xcc) ++before; } }
            if (npop != 8u) ok = 0u;
            MISC[2] = ok; MISC[3] = before; }
        __syncthreads();
        xloc = __builtin_amdgcn_readfirstlane((int)MISC[2]); xidx = __builtin_amdgcn_readfirstlane((int)MISC[3]); xrank = __builtin_amdgcn_readfirstlane((int)MISC[1]);
        if (xloc) { vcu = xidx * (G / 8) + xrank; cbx = xrank * 8 + xidx; gw = vcu * NWAVES + wave; }
    }
    const int rb = xloc ? xidx * (M / 8) : 0, re = xloc ? (xidx + 1) * (M / 8) : M, rgw = xloc ? xrank * NWAVES + wave : gw, RNGW = xloc ? (G / 8) * NWAVES : NGW;
    if (IN(1)) { pg8::Gemm g{XN, W1GU, M, 2 * FF, D}; pg8::StaticOrder S; S.init(M, 2 * FF, G, cbx); pg8::EpiSwiglu E{ACT, FF};
        pg8::gemm_phase<pg8::EpiSwiglu, pg8::StaticOrder, true, true>(lds, g, S, E); }
    LSEAM(1);
    if (IN(2)) { pg8::Gemm g{ACT, W1D, M, D, FF}; pg8::StaticOrder S; S.init(M, D, G, cbx); pg8::EpiRawSS E{FB, D, RPART};
        pg8::gemm_phase<pg8::EpiRawSS, pg8::StaticOrder, true, true>(lds, g, S, E); }
    LSEAM(2);
    if (IN(3)) fix_phase<0, true>(rgw, RNGW, rb, re, a.x, FB, RPART, 0.5f, a.g_post1, nullptr, a.g_mpre, ROWR, XN, nullptr, lane);
    SEAM(3);
    if (IN(4)) { pg8::Gemm g{XN, WIN, M, DIN, D}; pg8::StaticOrder S; S.init(M, DIN, G, cbx); pg8::EpiQKV E{QKV, DIN, 0.125f * 1.4426950408889634f};
        pg8::gemm_phase<pg8::EpiQKV, pg8::StaticOrder, true, true>(lds, g, S, E); }
    LSEAM(4);
    if (IN(5)) {
        for (int i = rb * 10 + (rgw * 64 + lane); i < re * 10; i += RNGW * 64) { const int tok = i / 10, hh = i - tok * 10;
            bf16* p = QKV + (size_t)tok * DIN + (hh < 8 ? 1536 + 64 * hh : 2048 + 64 * (hh - 8));
            const v4u a0 = *(const v4u*)p, a1 = *(const v4u*)(p + 8); const f32x4* rp = (const f32x4*)(ROPE + (size_t)tok * 16); const f32x4 c0 = rp[0], c1 = rp[1], s0 = rp[2], s1 = rp[3];
            float x1[8], x2[8];
#pragma unroll
            for (int k = 0; k < 4; ++k) { x1[2 * k] = __uint_as_float(a0[k] << 16); x1[2 * k + 1] = __uint_as_float(a0[k] & 0xffff0000u); x2[2 * k] = __uint_as_float(a1[k] << 16); x2[2 * k + 1] = __uint_as_float(a1[k] & 0xffff0000u); }
            const float cs[8] = {c0.x, c0.y, c0.z, c0.w, c1.x, c1.y, c1.z, c1.w}, sn[8] = {s0.x, s0.y, s0.z, s0.w, s1.x, s1.y, s1.z, s1.w};
            v4u o0, o1;
#pragma unroll
            for (int k = 0; k < 4; ++k) { o0[k] = pk2(x1[2 * k] * cs[2 * k] - x2[2 * k] * sn[2 * k], x1[2 * k + 1] * cs[2 * k + 1] - x2[2 * k + 1] * sn[2 * k + 1]);
                o1[k] = pk2(x2[2 * k] * cs[2 * k] + x1[2 * k] * sn[2 * k], x2[2 * k + 1] * cs[2 * k + 1] + x1[2 * k + 1] * sn[2 * k + 1]); }
            *(v4u*)p = o0; *(v4u*)(p + 8) = o1; }
        if (xloc) { ++lep; xcd_local_barrier((unsigned*)(ws + WS_CTL) + CW_XLB + 64 * xidx, lep * (unsigned)(G / 8)); } else xcd_barrier(bar);
        LAS float* bt = (LAS float*)(lds + att::LDS_BT);
        for (int i = tid; i < 8 * 320; i += NWAVES * 64) { const int hh = i / 320, k = i % 320; bt[hh * att::BT_STRIDE + k] = a.relb[hh * 257 + (k < 256 ? k : 256)] * 1.4426950408889634f; }
        __syncthreads();
        for (int u = vcu; u < BATCH * 32; u += G) {
            const int c = ((u & 7) + 8 * (u >> 8)) & 31, b = (u >> 3) & 31;
            att::attn_round<0>(QKV, OB, b, c, 0, lds, a.sinks, tid);
            att::attn_round<0>(QKV, OB, b, c, 1, lds, a.sinks, tid);
            att::attn_round<1>(QKV, OB, b, c, 0, lds, a.sinks, tid);
            att::attn_round<1>(QKV, OB, b, c, 1, lds, a.sinks, tid);
        }
        __syncthreads();
    }
    LSEAM(5);
    if (IN(6)) { pg8::Gemm g{OB, WOUT, M, D, D}; pg8::StaticOrder S; S.init(M, D, G, cbx); pg8::EpiRawSS E{FB, D, RPART};
        pg8::gemm_phase<pg8::EpiRawSS, pg8::StaticOrder, true, true>(lds, g, S, E); }
    LSEAM(6);
    if (IN(7)) fix_phase<0, false>(rgw, RNGW, rb, re, nullptr, FB, RPART, 1.0f, a.g_mpost, a.g_mpre, a.g_pre2, ROWR, XN, nullptr, lane);
    SEAM(7);
    if (IN(8)) { pg8::Gemm g{XN, W2GU, M, 2 * FF, D}; pg8::StaticOrder S; S.init(M, 2 * FF, G, cbx); pg8::EpiSwiglu E{ACT, FF};
        pg8::gemm_phase<pg8::EpiSwiglu, pg8::StaticOrder, true, true>(lds, g, S, E); }
    LSEAM(8);
    if (IN(9)) { pg8::Gemm g{ACT, W2D, M, D, FF}; pg8::StaticOrder S; S.init(M, D, G, cbx); pg8::EpiRawSS E{FB, D, RPART};
        pg8::gemm_phase<pg8::EpiRawSS, pg8::StaticOrder, true, true>(lds, g, S, E); }
    LSEAM(9);
    if (IN(10)) fix_phase<1, false>(rgw, RNGW, rb, re, nullptr, FB, RPART, 0.5f, a.g_post2, a.g_pre2, a.g_fin, ROWR, XN, a.out, lane);
#undef IN
#undef SEAM
#undef LSEAM
}

extern "C" void kernel_launch(void* const* d_in, const int* in_sizes, int n_in, void* d_out, int out_size, void* d_ws, size_t ws_size, hipStream_t stream) {
    static int grid = 0;
    if (grid == 0) {
        if (n_in != 19 || in_sizes[0] != M * D || out_size != M * D || ws_size < WS_END) { fprintf(stderr, "kernel_launch: unexpected shapes (n_in %d, in0 %d, out %d, ws %zu)\n", n_in, n_in > 0 ? in_sizes[0] : -1, out_size, ws_size); grid = -1; return; }
        int dev = 0, cus = 0, per_cu = 0;
        if (hipGetDevice(&dev) != hipSuccess || hipDeviceGetAttribute(&cus, hipDeviceAttributeMultiprocessorCount, dev) != hipSuccess) { grid = -1; return; }
        if (hipFuncSetAttribute((const void*)mk_fwd, hipFuncAttributeMaxDynamicSharedMemorySize, LDS_BYTES) != hipSuccess) { fprintf(stderr, "kernel_launch: hipFuncSetAttribute failed\n"); grid = -1; return; }
        if (hipOccupancyMaxActiveBlocksPerMultiprocessor(&per_cu, (const void*)mk_fwd, NWAVES * 64, LDS_BYTES) != hipSuccess || per_cu < 1) { fprintf(stderr, "kernel_launch: occupancy query says %d\n", per_cu); per_cu = 1; }
        (void)hipGetLastError();
        grid = cus * 1;
    }
    if (grid < 0) return;
    if (hipMemsetAsync((char*)d_ws + WS_CTL, 0, CTL_ZERO_BYTES, stream) != hipSuccess) { fprintf(stderr, "kernel_launch: memset failed\n"); return; }
    Args a{};
    a.x = (const float*)d_in[0]; a.pos = (const int*)d_in[1]; a.g_pre1 = (const float*)d_in[2]; a.w1g = (const float*)d_in[3]; a.w1u = (const float*)d_in[4]; a.w1d = (const float*)d_in[5];
    a.g_post1 = (const float*)d_in[6]; a.g_mpre = (const float*)d_in[7]; a.w_in = (const float*)d_in[8]; a.relb = (const float*)d_in[9]; a.sinks = (const float*)d_in[10]; a.w_out = (const float*)d_in[11];
    a.g_mpost = (const float*)d_in[12]; a.g_pre2 = (const float*)d_in[13]; a.w2g = (const float*)d_in[14]; a.w2u = (const float*)d_in[15]; a.w2d = (const float*)d_in[16]; a.g_post2 = (const float*)d_in[17]; a.g_fin = (const float*)d_in[18];
    a.out = (float*)d_out; a.ws = (unsigned char*)d_ws;
    for (int j = 0; j < 8; ++j) a.invf[j] = (float)std::pow(500000.0, -(double)j / 8.0);
#if MK_PER_PHASE
    for (int p = 0; p < NPHASE; ++p) { a.ph_lo = p; a.ph_hi = p + 1; hipLaunchKernelGGL(mk_fwd, dim3(grid), dim3(NWAVES * 64), LDS_BYTES, stream, a); }
#else
    a.ph_lo = 0; a.ph_hi = NPHASE;
    void* args[] = {&a};
    hipError_t e = hipLaunchCooperativeKernel((const void*)mk_fwd, dim3(grid), dim3(NWAVES * 64), args, LDS_BYTES, stream);
    if (e != hipSuccess) fprintf(stderr, "cooperative launch failed: %s (grid %d)\n", hipGetErrorString(e), grid);
#endif
}
```

```cpp
#include <hip/hip_runtime.h>
#include <hip/hip_cooperative_groups.h>
#include <cstdio>
#include <cstdint>
#include <cmath>
namespace cg = cooperative_groups;
namespace pg8 {
#define PG8_LAS __attribute__((address_space(3)))
typedef unsigned short bf16_t;
typedef short bf16x8 __attribute__((ext_vector_type(8)));
typedef float f32x4 __attribute__((ext_vector_type(4)));
typedef unsigned u32x4 __attribute__((ext_vector_type(4)));
constexpr int BM = 256, BK = 64, HALF = 128, HTB = HALF * BK * 2  , STAGE_BYTES = 8 * HTB, NXCD = 8, WGM = 8;

__host__ __device__ __forceinline__ int lds_byte(int r, int c) { const int st = (r >> 4) * 2 + (c >> 5), rr = r & 15, cc = c & 31, ob = rr * 64 + cc * 2; return st * 1024 + (ob ^ (((ob >> 9) & 1) << 5)); }
__host__ __device__ __forceinline__ void stage_rc(int b, int& R, int& C) { const int st = b / 1024, sb = b % 1024, swz = sb ^ (((sb >> 9) & 1) << 5); R = (st >> 1) * 16 + swz / 64; C = (st & 1) * 32 + (swz % 64) / 2; }
__host__ __device__ __forceinline__ int perm32(int rho) { const int n = rho >> 4, i = rho & 15; return 8 * (i >> 2) + 4 * n + (i & 3); }

struct Unit { int pm, pn; };
struct Gemm { const bf16_t* A; const bf16_t* Bt; int M, N, K; };

struct StaticOrder {
    int nM, nN, nwg, G, c;
    __host__ __device__ void init(int M, int N, int G_, int c_) { nM = M / BM; nN = N / BM; nwg = nM * nN; G = G_; c = c_; }
    __host__ __device__ bool next(int i, Unit& u) const {
        const long L = (long)i * G + c; if (L >= nwg) return false;
        int wgid = (int)L; { const int q = nwg / NXCD, r = nwg % NXCD, xcd = wgid % NXCD, off = wgid / NXCD; wgid = (xcd < r ? xcd * (q + 1) : r * (q + 1) + (xcd - r) * q) + off; }
        const int nig = WGM * nN, gid = wgid / nig, fm = gid * WGM, gsz = (nM - fm) < WGM ? (nM - fm) : WGM;
        u.pm = fm + ((wgid % nig) % gsz); u.pn = (wgid % nig) / gsz; return true;
    }
    __device__ __forceinline__ void a_ready(const Unit&) const {}
    __device__ __forceinline__ void done(const Unit&) const {}
};

__device__ __forceinline__ unsigned cvt_pk_bf16(float lo, float hi) { unsigned r; asm volatile("v_cvt_pk_bf16_f32 %0, %1, %2" : "=v"(r) : "v"(lo), "v"(hi)); return r; }
__device__ __forceinline__ float silu_mul(float g, float u) { return g * u * __builtin_amdgcn_rcpf(1.0f + __builtin_amdgcn_exp2f(-1.4426950408889634f * g)); }
struct EpiSwiglu {
    static constexpr bool PERM = true, AFTER_DRAIN = false;
    bf16_t* O; int ldc;
    __device__ __forceinline__ void operator()(const f32x4 (&acc)[2][2][4][2], const Unit& u, int wr, int wc, int fr, int fq) const {
        const int row0 = u.pm * BM + wr * 64 + fr; const int col0 = u.pn * HALF + wc * 32 + 8 * fq;
#pragma unroll
        for (int ai = 0; ai < 2; ++ai)
#pragma unroll
            for (int m = 0; m < 4; ++m) { bf16_t* rowp = O + (size_t)(row0 + ai * HALF + m * 16) * ldc + col0;
                const f32x4 g0 = acc[ai][0][m][0], g1 = acc[ai][0][m][1], u0 = acc[ai][1][m][0], u1 = acc[ai][1][m][1];
                u32x4 w; w.x = cvt_pk_bf16(silu_mul(g0[0], u0[0]), silu_mul(g0[1], u0[1])); w.y = cvt_pk_bf16(silu_mul(g0[2], u0[2]), silu_mul(g0[3], u0[3]));
                w.z = cvt_pk_bf16(silu_mul(g1[0], u1[0]), silu_mul(g1[1], u1[1])); w.w = cvt_pk_bf16(silu_mul(g1[2], u1[2]), silu_mul(g1[3], u1[3]));
                *(u32x4*)rowp = w; }
    }
};
struct EpiRawSS {
    static constexpr bool PERM = true, AFTER_DRAIN = false;
    bf16_t* O; int ldc; float* rowpart;
    __device__ __forceinline__ void operator()(const f32x4 (&acc)[2][2][4][2], const Unit& u, int wr, int wc, int fr, int fq) const {
        const int row0 = u.pm * BM + wr * 64 + fr; const int col0 = u.pn * BM + wc * 32 + 8 * fq;
#pragma unroll
        for (int ai = 0; ai < 2; ++ai)
#pragma unroll
            for (int m = 0; m < 4; ++m) { const int row = row0 + ai * HALF + m * 16; bf16_t* rowp = O + (size_t)row * ldc + col0; float s = 0.f;
#pragma unroll
                for (int bj = 0; bj < 2; ++bj) { const f32x4 v0 = acc[ai][bj][m][0], v1 = acc[ai][bj][m][1];
                    s += (v0[0] * v0[0] + v0[1] * v0[1]) + (v0[2] * v0[2] + v0[3] * v0[3]) + (v1[0] * v1[0] + v1[1] * v1[1]) + (v1[2] * v1[2] + v1[3] * v1[3]);
                    u32x4 w; w.x = cvt_pk_bf16(v0[0], v0[1]); w.y = cvt_pk_bf16(v0[2], v0[3]); w.z = cvt_pk_bf16(v1[0], v1[1]); w.w = cvt_pk_bf16(v1[2], v1[3]);
                    *(u32x4*)(rowp + bj * HALF) = w; }
                s += __shfl_xor(s, 16); s += __shfl_xor(s, 32);
                if (fq == 0) rowpart[(size_t)row * 16 + u.pn * 4 + wc] = s; }
    }
};
struct EpiQKV {
    static constexpr bool PERM = true, AFTER_DRAIN = false;
    bf16_t* O; int ldc; float qscale;
    __device__ __forceinline__ void operator()(const f32x4 (&acc)[2][2][4][2], const Unit& u, int wr, int wc, int fr, int fq) const {
        const int row0 = u.pm * BM + wr * 64 + fr; const int col0 = u.pn * BM + wc * 32 + 8 * fq;
        const float sc = (u.pn < 2 || u.pn == 6 || u.pn == 7) ? qscale : 1.0f;
#pragma unroll
        for (int ai = 0; ai < 2; ++ai)
#pragma unroll
            for (int m = 0; m < 4; ++m) { const int row = row0 + ai * HALF + m * 16; bf16_t* rowp = O + (size_t)row * ldc + col0;
#pragma unroll
                for (int bj = 0; bj < 2; ++bj) { const f32x4 v0 = acc[ai][bj][m][0] * sc, v1 = acc[ai][bj][m][1] * sc;
                    u32x4 w; w.x = cvt_pk_bf16(v0[0], v0[1]); w.y = cvt_pk_bf16(v0[2], v0[3]); w.z = cvt_pk_bf16(v1[0], v1[1]); w.w = cvt_pk_bf16(v1[2], v1[3]);
                    *(u32x4*)(rowp + bj * HALF) = w; } }
    }
};
template <class Epi, class Sched, bool ALIGN_EPI = false, bool SP2 = false>
__device__ __forceinline__ void gemm_phase(PG8_LAS unsigned char* lds, const Gemm g, const Sched& S, const Epi& E) {
    const int tid = threadIdx.x, wid = __builtin_amdgcn_readfirstlane(tid >> 6), lane = tid & 63, wr = wid >> 2, wc = wid & 3, fr = lane & 15, fq = lane >> 4;
    const int K = g.K, nt = K / BK;
    unsigned voffA[2], voffB[2];
#pragma unroll
    for (int i = 0; i < 2; ++i) { int R, C; stage_rc(tid * 16 + i * 8192, R, C); const int Rb = Epi::PERM ? ((R & ~31) + perm32(R & 31)) : R;
        voffA[i] = (unsigned)(R * K + C) * 2u; voffB[i] = (unsigned)(Rb * K + C) * 2u; }
    const size_t kstep = (size_t)(BK * 2);
    const size_t hstep = (size_t)HALF * K * 2;
    const size_t tstep = 2 * hstep;
    const unsigned ldsw = (unsigned)wid * 1024u;
    const int aoff = lds_byte(wr * 64 + fr, fq * 8), boff = lds_byte(wc * 32 + fr, fq * 8);
#define PG8_SA(b, h) (((b) * 2 + (h)) * HTB)
#define PG8_SB(b, h) ((4 + (b) * 2 + (h)) * HTB)
#define PG8_STAGE(bufoff, gbase, voff) do { _Pragma("unroll") for (int _i = 0; _i < 2; ++_i) \
        __builtin_amdgcn_global_load_lds((const unsigned*)((const char*)(gbase) + (voff)[_i]), (PG8_LAS unsigned*)(lds + (bufoff) + ldsw + _i * 8192), 16, 0, 0); } while (0)
#define PG8_LDA(dst, b, h) do { _Pragma("unroll") for (int m = 0; m < 4; ++m) _Pragma("unroll") for (int k = 0; k < 2; ++k) dst[m][k] = *(const PG8_LAS bf16x8*)(lds + PG8_SA(b, h) + aoff + m * 2048 + k * 1024); } while (0)
#define PG8_LDB(dst, b, h) do { _Pragma("unroll") for (int n = 0; n < 2; ++n) _Pragma("unroll") for (int k = 0; k < 2; ++k) dst[n][k] = *(const PG8_LAS bf16x8*)(lds + PG8_SB(b, h) + boff + n * 2048 + k * 1024); } while (0)
#define PG8_MMA(ai, bj, At, Bt) do { __builtin_amdgcn_s_setprio(1); _Pragma("unroll") for (int m = 0; m < 4; ++m) _Pragma("unroll") for (int n = 0; n < 2; ++n) _Pragma("unroll") for (int k = 0; k < 2; ++k) \
        acc[ai][bj][m][n] = __builtin_amdgcn_mfma_f32_16x16x32_bf16(Bt[n][k], At[m][k], acc[ai][bj][m][n], 0, 0, 0); __builtin_amdgcn_s_setprio(0); } while (0)
#define PG8_WAIT_V(n) asm volatile("s_waitcnt vmcnt(" #n ")" ::: "memory")
#define PG8_WAIT_L(n) asm volatile("s_waitcnt lgkmcnt(" #n ")" ::: "memory")
#define PG8_BAR __builtin_amdgcn_s_barrier()
#define PG8_SCHED __builtin_amdgcn_sched_barrier(0)
    Unit cur, nxt; int ui = 0;
    if (!S.next(0, cur)) return;
    f32x4 acc[2][2][4][2];
#pragma unroll
    for (int a = 0; a < 2; ++a)
#pragma unroll
        for (int b = 0; b < 2; ++b)
#pragma unroll
            for (int m = 0; m < 4; ++m)
#pragma unroll
                for (int n = 0; n < 2; ++n) acc[a][b][m][n] = (f32x4){0.f, 0.f, 0.f, 0.f};
    bf16x8 At[4][2], B0[2][2], B1[2][2];
    const char* cA = (const char*)g.A + (size_t)cur.pm * tstep; const char* cB = (const char*)g.Bt + (size_t)cur.pn * tstep;
    S.a_ready(cur);
    if constexpr (SP2) {
        PG8_STAGE(PG8_SB(0, 0), cB, voffB); PG8_STAGE(PG8_SB(0, 1), cB + hstep, voffB); PG8_STAGE(PG8_SA(0, 0), cA, voffA); PG8_STAGE(PG8_SA(0, 1), cA + hstep, voffA);
        if (wr == 1) PG8_BAR;
        PG8_WAIT_V(2); PG8_BAR;
        PG8_STAGE(PG8_SB(1, 0), cB + kstep, voffB); PG8_STAGE(PG8_SA(1, 0), cA + kstep, voffA); PG8_STAGE(PG8_SB(1, 1), cB + hstep + kstep, voffB);
        PG8_WAIT_V(6); PG8_BAR;
    } else {
        PG8_STAGE(PG8_SB(0, 0), cB, voffB); PG8_STAGE(PG8_SA(0, 0), cA, voffA); PG8_STAGE(PG8_SB(0, 1), cB + hstep, voffB); PG8_STAGE(PG8_SA(0, 1), cA + hstep, voffA);
        if (wr == 1) PG8_BAR;
        PG8_WAIT_V(4); PG8_BAR;
        PG8_STAGE(PG8_SB(1, 0), cB + kstep, voffB); PG8_STAGE(PG8_SA(1, 0), cA + kstep, voffA); PG8_STAGE(PG8_SB(1, 1), cB + hstep + kstep, voffB);
        PG8_WAIT_V(6); PG8_BAR;
    }
    for (;;) {
        const bool has_next = S.next(ui + 1, nxt);
        const char* nA = has_next ? (const char*)g.A + (size_t)nxt.pm * tstep : cA; const char* nB = has_next ? (const char*)g.Bt + (size_t)nxt.pn * tstep : cB;
        for (int t = 0; t < nt; t += 2) {
            const bool last = (t == nt - 2);
            const char* a1 = cA + (size_t)(t + 1) * kstep;
            const char* a2 = last ? nA : cA + (size_t)(t + 2) * kstep; const char* b2 = last ? nB : cB + (size_t)(t + 2) * kstep;
            const char* a3 = a2 + kstep; const char* b3 = b2 + kstep;
            if (last && has_next) S.a_ready(nxt);
            if constexpr (SP2) {
            PG8_LDB(B0, 0, 0); PG8_LDB(B1, 0, 1); PG8_SCHED; PG8_LDA(At, 0, 0); PG8_STAGE(PG8_SA(1, 1), a1 + hstep, voffA);
            PG8_WAIT_V(8); PG8_WAIT_L(0); PG8_BAR; PG8_MMA(0, 0, At, B0); PG8_MMA(0, 1, At, B1); PG8_BAR; PG8_SCHED;
            PG8_LDA(At, 0, 1); PG8_STAGE(PG8_SB(0, 0), b2, voffB); PG8_STAGE(PG8_SB(0, 1), b2 + hstep, voffB); PG8_STAGE(PG8_SA(0, 0), a2, voffA);
            PG8_WAIT_V(8); PG8_WAIT_L(0); PG8_BAR; PG8_MMA(1, 0, At, B0); PG8_MMA(1, 1, At, B1); PG8_BAR; PG8_SCHED;
            PG8_LDB(B0, 1, 0); PG8_LDB(B1, 1, 1); PG8_SCHED; PG8_LDA(At, 1, 0); PG8_STAGE(PG8_SA(0, 1), a2 + hstep, voffA);
            PG8_WAIT_V(8); PG8_WAIT_L(0); PG8_BAR; PG8_MMA(0, 0, At, B0); PG8_MMA(0, 1, At, B1); PG8_BAR; PG8_SCHED;
            PG8_LDA(At, 1, 1); PG8_STAGE(PG8_SB(1, 0), b3, voffB); PG8_STAGE(PG8_SB(1, 1), b3 + hstep, voffB); PG8_STAGE(PG8_SA(1, 0), a3, voffA);
            PG8_WAIT_V(8); PG8_WAIT_L(0); PG8_BAR; PG8_MMA(1, 0, At, B0); PG8_MMA(1, 1, At, B1); PG8_BAR; PG8_SCHED;
            } else {
            PG8_LDB(B0, 0, 0); PG8_SCHED; PG8_LDA(At, 0, 0); PG8_STAGE(PG8_SA(1, 1), a1 + hstep, voffA);
            PG8_WAIT_L(8); PG8_BAR; PG8_WAIT_L(0); PG8_MMA(0, 0, At, B0); PG8_BAR; PG8_SCHED;
            PG8_LDB(B1, 0, 1); PG8_STAGE(PG8_SB(0, 0), b2, voffB);
            PG8_BAR; PG8_WAIT_L(0); PG8_MMA(0, 1, At, B1); PG8_BAR;
            PG8_LDA(At, 0, 1); PG8_STAGE(PG8_SA(0, 0), a2, voffA);
            PG8_BAR; PG8_WAIT_L(0); PG8_MMA(1, 0, At, B0); PG8_BAR; PG8_SCHED;
            PG8_STAGE(PG8_SB(0, 1), b2 + hstep, voffB);
            PG8_WAIT_V(6); PG8_BAR; PG8_MMA(1, 1, At, B1); PG8_BAR;
            PG8_LDB(B0, 1, 0); PG8_SCHED; PG8_LDA(At, 1, 0); PG8_STAGE(PG8_SA(0, 1), a2 + hstep, voffA);
            PG8_WAIT_L(8); PG8_BAR; PG8_WAIT_L(0); PG8_MMA(0, 0, At, B0); PG8_BAR; PG8_SCHED;
            PG8_LDB(B1, 1, 1); PG8_STAGE(PG8_SB(1, 0), b3, voffB);
            PG8_BAR; PG8_WAIT_L(0); PG8_MMA(0, 1, At, B1); PG8_BAR;
            PG8_LDA(At, 1, 1); PG8_STAGE(PG8_SA(1, 0), a3, voffA);
            PG8_BAR; PG8_WAIT_L(0); PG8_MMA(1, 0, At, B0); PG8_BAR; PG8_SCHED;
            PG8_STAGE(PG8_SB(1, 1), b3 + hstep, voffB);
            PG8_WAIT_V(6); PG8_BAR; PG8_MMA(1, 1, At, B1); PG8_BAR;
            }
        }
        if constexpr (ALIGN_EPI) { if (wr == 0) PG8_BAR; }
        if constexpr (!Epi::AFTER_DRAIN) { E(acc, cur, wr, wc, fr, fq); S.done(cur); }
        if (!has_next) break;
#pragma unroll
        for (int a = 0; a < 2; ++a)
#pragma unroll
            for (int b = 0; b < 2; ++b)
#pragma unroll
                for (int m = 0; m < 4; ++m)
#pragma unroll
                    for (int n = 0; n < 2; ++n) acc[a][b][m][n] = (f32x4){0.f, 0.f, 0.f, 0.f};
        cur = nxt; cA = nA; cB = nB; ++ui;
        if constexpr (ALIGN_EPI) { if (wr == 1) PG8_BAR; }
    }
    PG8_WAIT_V(0);
    if constexpr (!ALIGN_EPI) { if (wr == 0) PG8_BAR; }
    PG8_BAR;
    if constexpr (Epi::AFTER_DRAIN) { E.fused(acc, cur, wr, wc, fr, fq, lds, wid, lane); S.done(cur); }
#undef PG8_SA
#undef PG8_SB
#undef PG8_STAGE
#undef PG8_LDA
#undef PG8_LDB
#undef PG8_MMA
#undef PG8_WAIT_V
#undef PG8_WAIT_L
#undef PG8_BAR
#undef PG8_SCHED
}
}
namespace att {
#define ATT_LAS __attribute__((address_space(3)))
typedef unsigned short bf16_t;
typedef short bf16x8 __attribute__((ext_vector_type(8)));
typedef short s16x4 __attribute__((ext_vector_type(4)));
typedef float f32x16 __attribute__((ext_vector_type(16)));
typedef unsigned u32x4 __attribute__((ext_vector_type(4)));
typedef unsigned u32x2 __attribute__((ext_vector_type(2)));
constexpr int QKV_LD = 2304, O_LD = 1024, SEQ = 2048, CHUNK = 64;
constexpr int BT_STRIDE = 324;
constexpr int KROW = 144, KTILE = 64 * KROW, VTILE = 8192, LDS_V = 4 * KTILE, LDS_BT = LDS_V + 4 * VTILE, LDS_END = LDS_BT + 8 * BT_STRIDE * 4;
constexpr float THR = 8.0f;
__device__ __forceinline__ int crow(int r, int hi) { return (r & 3) + 8 * (r >> 2) + 4 * hi; }
__device__ __forceinline__ unsigned cvtpk(float lo, float hi) { unsigned r; asm volatile("v_cvt_pk_bf16_f32 %0, %1, %2" : "=v"(r) : "v"(lo), "v"(hi)); return r; }
__device__ __forceinline__ s16x4 vtr(const ATT_LAS unsigned char* p) { return __builtin_bit_cast(s16x4, __builtin_amdgcn_ds_read_tr16_b64_v4i16((ATT_LAS s16x4*)p)); }

template <int KIND>
__device__ __forceinline__ void attn_round(const bf16_t* __restrict__ QKV, bf16_t* __restrict__ O, int b, int c, int g, ATT_LAS unsigned char* lds, const float* sinks, int tid) {
    constexpr int L = KIND == 0 ? 8 : 2, NH = KIND == 0 ? 4 : 1;
    const int lane = tid & 63, wave = tid >> 6, r32 = lane & 31, hi = lane >> 5;
    const int h = 4 * g + (wave >> 1), qhalf = wave & 1, hs = KIND == 0 ? (wave >> 1) : 0;
    const int qcol = KIND == 0 ? h * 64 : 1536 + h * 64;
    const int ocol = KIND == 0 ? h * 64 : 512 + h * 64;
    const int kcol0 = KIND == 0 ? 512 + 256 * g : 2048 + 64 * g;
    const int vcol0 = KIND == 0 ? 1024 + 256 * g : 2176 + 64 * g;
    const long tok0 = (long)b * SEQ + c * CHUNK;
    const int j0 = (L - c) > 0 ? (L - c) : 0;
    const int lrow = tid >> 3, lch = tid & 7;
    const bf16_t* kg = QKV + (size_t)(tok0 - L * CHUNK + lrow) * QKV_LD + kcol0 + 8 * lch;
    const bf16_t* vg = QKV + (size_t)(tok0 - L * CHUNK + lrow) * QKV_LD + vcol0 + 8 * lch;
    const int kw = lrow * KROW + lch * 16;
    const int vw = LDS_V + (lch >> 2) * 4096 + (lrow >> 4) * 1024 + ((lrow >> 3) & 1) * 512 + (lrow & 7) * 64 + (lch & 3) * 16;
    u32x4 kr[NH], vr[NH];
#pragma unroll
    for (int i = 0; i < NH; ++i) { kr[i] = *(const u32x4*)(kg + (size_t)(j0 * 64) * QKV_LD + 64 * i); vr[i] = *(const u32x4*)(vg + (size_t)(j0 * 64) * QKV_LD + 64 * i); }
    bf16x8 qr[4];
    { const bf16_t* qp = QKV + (size_t)(tok0 + qhalf * 32 + r32) * QKV_LD + qcol + 8 * hi;
#pragma unroll
      for (int d0 = 0; d0 < 4; ++d0) qr[d0] = *(const bf16x8*)(qp + 16 * d0); }
    const ATT_LAS unsigned char* kl = lds + hs * KTILE + r32 * KROW + 16 * hi;
    const ATT_LAS unsigned char* vl = lds + LDS_V + hs * VTILE + (4 * hi + ((lane & 15) >> 2)) * 64 + ((lane >> 4) & 1) * 32 + (lane & 3) * 8;
    const ATT_LAS float* bt = (const ATT_LAS float*)(lds + LDS_BT) + h * BT_STRIDE;
    float m = KIND == 0 ? 0.0f : sinks[h] * 1.4426950408889634f, l = (KIND == 1 && hi == 0) ? 1.0f : 0.0f;
    f32x16 o[2]; o[0] = f32x16{}; o[1] = f32x16{};
    const float cb = KIND == 0 ? bt[256] : 0.f;
    f32x16 csp;
#pragma unroll
    for (int r = 0; r < 16; ++r) csp[r] = cb - m;
    const int iq = qhalf * 32 + r32;
    for (int j = j0; j <= L; ++j) {
        __syncthreads();
#pragma unroll
        for (int i = 0; i < NH; ++i) { *(ATT_LAS u32x4*)(lds + i * KTILE + kw) = kr[i]; *(ATT_LAS u32x4*)(lds + i * VTILE + vw) = vr[i]; }
        __syncthreads();
        if (j < L) {
#pragma unroll
            for (int i = 0; i < NH; ++i) { kr[i] = *(const u32x4*)(kg + (size_t)((j + 1) * 64) * QKV_LD + 64 * i); vr[i] = *(const u32x4*)(vg + (size_t)((j + 1) * 64) * QKV_LD + 64 * i); }
        }
        f32x16 p[2];
        if (KIND == 0 && j >= 6) {
            const ATT_LAS float* btl = bt + (640 + iq - 4 * hi - 64 * j);
#pragma unroll
            for (int kb = 0; kb < 2; ++kb)
#pragma unroll
                for (int r = 0; r < 16; ++r) p[kb][r] = btl[-(32 * kb + (r & 3) + 8 * (r >> 2))] - m;
#pragma unroll
            for (int kb = 0; kb < 2; ++kb)
#pragma unroll
                for (int d0 = 0; d0 < 4; ++d0) { const bf16x8 kf = *(const ATT_LAS bf16x8*)(kl + kb * 32 * KROW + d0 * 32); p[kb] = __builtin_amdgcn_mfma_f32_32x32x16_bf16(kf, qr[d0], p[kb], 0, 0, 0); }
        } else {
#pragma unroll
            for (int kb = 0; kb < 2; ++kb)
#pragma unroll
                for (int d0 = 0; d0 < 4; ++d0) { const bf16x8 kf = *(const ATT_LAS bf16x8*)(kl + kb * 32 * KROW + d0 * 32);
                    if (d0 == 0) p[kb] = __builtin_amdgcn_mfma_f32_32x32x16_bf16(kf, qr[d0], csp, 0, 0, 0); else p[kb] = __builtin_amdgcn_mfma_f32_32x32x16_bf16(kf, qr[d0], p[kb], 0, 0, 0); }
        }
        float mx = fmaxf(fmaxf(p[0][0], p[0][1]), p[1][0]);
#pragma unroll
        for (int r = 2; r < 16; r += 2) mx = fmaxf(fmaxf(mx, p[0][r]), p[0][r + 1]);
#pragma unroll
        for (int r = 1; r < 16; r += 2) mx = fmaxf(fmaxf(mx, p[1][r]), p[1][(r + 1) & 15]);
        mx = fmaxf(mx, __shfl_xor(mx, 32));
        if (KIND == 0 && j == j0) {
            m = mx;
#pragma unroll
            for (int r = 0; r < 16; ++r) { p[0][r] -= mx; p[1][r] -= mx; csp[r] = cb - m; }
        } else if (__any(mx > THR)) {
            const float dl = fmaxf(mx, 0.f), f = __builtin_amdgcn_exp2f(-dl); m += dl; l *= f;
#pragma unroll
            for (int r = 0; r < 16; ++r) { o[0][r] *= f; o[1][r] *= f; p[0][r] -= dl; p[1][r] -= dl; csp[r] = cb - m; }
        }
        float ls0 = 0.f, ls1 = 0.f;
#pragma unroll
        for (int r = 0; r < 16; ++r) { p[0][r] = __builtin_amdgcn_exp2f(p[0][r]); p[1][r] = __builtin_amdgcn_exp2f(p[1][r]); ls0 += p[0][r]; ls1 += p[1][r]; }
        l += ls0 + ls1;
#pragma unroll
        for (int ks = 0; ks < 4; ++ks) { const int kb = ks >> 1, s = ks & 1;
            u32x4 pw; pw.x = cvtpk(p[kb][8 * s + 0], p[kb][8 * s + 1]); pw.y = cvtpk(p[kb][8 * s + 2], p[kb][8 * s + 3]); pw.z = cvtpk(p[kb][8 * s + 4], p[kb][8 * s + 5]); pw.w = cvtpk(p[kb][8 * s + 6], p[kb][8 * s + 7]);
            const bf16x8 pa = __builtin_bit_cast(bf16x8, pw);
#pragma unroll
            for (int d0 = 0; d0 < 2; ++d0) { const s16x4 lo = vtr(vl + d0 * 4096 + ks * 1024), hh = vtr(vl + d0 * 4096 + ks * 1024 + 512);
                const bf16x8 vf = (bf16x8){lo[0], lo[1], lo[2], lo[3], hh[0], hh[1], hh[2], hh[3]};
                o[d0] = __builtin_amdgcn_mfma_f32_32x32x16_bf16(vf, pa, o[d0], 0, 0, 0); } }
    }
    l += __shfl_xor(l, 32);
    const float inv = 1.0f / l;
    bf16_t* op = O + (size_t)(tok0 + qhalf * 32 + r32) * O_LD + ocol + 4 * hi;
#pragma unroll
    for (int d0 = 0; d0 < 2; ++d0)
#pragma unroll
        for (int gq = 0; gq < 4; ++gq) { u32x2 w; w.x = cvtpk(o[d0][4 * gq] * inv, o[d0][4 * gq + 1] * inv); w.y = cvtpk(o[d0][4 * gq + 2] * inv, o[d0][4 * gq + 3] * inv);
            *(u32x2*)(op + 32 * d0 + 8 * gq) = w; }
}
}
constexpr int NWAVES = 8;
#ifndef MK_PER_PHASE
#define MK_PER_PHASE 0
#endif
constexpr int NPHASE = 11;
constexpr int BATCH = 32, SEQ = 2048, D = 1024, FF = 2816, DIN = 2304, M = BATCH * SEQ;
constexpr float EPS = 1e-6f;
constexpr size_t MiB = 1u << 20;
constexpr size_t WS_W1GU = 2 * MiB, WS_W1D = 14 * MiB, WS_WIN = 20 * MiB, WS_WOUT = 25 * MiB, WS_W2GU = 28 * MiB, WS_W2D = 40 * MiB, WS_ROPE = 46 * MiB, WS_RPART = 50 * MiB;
constexpr size_t WS_XN = 64 * MiB;
constexpr size_t WS_ACT = 192 * MiB;
constexpr size_t WS_F = 544 * MiB;
constexpr size_t WS_H = 672 * MiB;
constexpr size_t WS_ROWR = 56 * MiB;
constexpr size_t WS_END = 800 * MiB;
constexpr int LDS_BYTES = 147456;
constexpr size_t WS_CTL = 0, CTL_ZERO_BYTES = 65536;
constexpr int CW_BAR = 4096, CW_XCNT = 8192, CW_XLB = 10240;

#define LAS __attribute__((address_space(3)))
typedef unsigned short bf16;
typedef unsigned v4u __attribute__((ext_vector_type(4)));
typedef unsigned v2u __attribute__((ext_vector_type(2)));
typedef float f32x4 __attribute__((ext_vector_type(4)));
__device__ __forceinline__ unsigned pk2(float lo, float hi) { return pg8::cvt_pk_bf16(lo, hi); }
__device__ __forceinline__ float bf2f(unsigned short v) { return __uint_as_float((unsigned)v << 16); }
template <int CTRL> __device__ __forceinline__ float dpp_add(float v) { return v + __int_as_float(__builtin_amdgcn_update_dpp(0, __float_as_int(v), CTRL, 0xF, 0xF, true)); }
__device__ __forceinline__ float wave_sum(float v) {
    v = dpp_add<0xB1>(v); v = dpp_add<0x4E>(v); v = dpp_add<0x141>(v); v = dpp_add<0x140>(v);
    { auto rr = __builtin_amdgcn_permlane16_swap(__float_as_uint(v), __float_as_uint(v), false, false); v = __uint_as_float(rr[0]) + __uint_as_float(rr[1]); }
    { auto rr = __builtin_amdgcn_permlane32_swap(__float_as_uint(v), __float_as_uint(v), false, false); v = __uint_as_float(rr[0]) + __uint_as_float(rr[1]); }
    return v;
}
__device__ __forceinline__ void p0_transpose_item(const float* W, int K, int N, bf16* WT, int mode, LAS float* scr, int item, int lane) {
    const int nblk = N / 32, kb = item / nblk, nb = item % nblk, k0 = 64 * kb, n0 = 32 * nb;
    const int drow0 = mode == 0 ? n0 : ((n0 >> 7) * 256 + (n0 & 127) + (mode == 2 ? 128 : 0));
#pragma unroll 8
    for (int i = 0; i < 32; ++i) { const int kk = 2 * i + (lane >> 5); scr[kk * 33 + (lane & 31)] = W[(size_t)(k0 + kk) * N + n0 + (lane & 31)]; }
    asm volatile("s_waitcnt lgkmcnt(0)" ::: "memory");
    const int c = lane & 7;
#pragma unroll
    for (int j = 0; j < 4; ++j) { const int n = (lane >> 3) + 8 * j; const LAS float* s = scr + (8 * c) * 33 + n;
        v4u o; o.x = pk2(s[0 * 33], s[1 * 33]); o.y = pk2(s[2 * 33], s[3 * 33]); o.z = pk2(s[4 * 33], s[5 * 33]); o.w = pk2(s[6 * 33], s[7 * 33]);
        *(v4u*)(WT + (size_t)(drow0 + n) * K + k0 + 8 * c) = o; }
    asm volatile("s_waitcnt lgkmcnt(0)" ::: "memory");
}
#define XB_TMO      128
#define XB_XCNT(j)  (256  + 64 * (j))
#define XB_XSUB(j)  (1280 + 64 * (j))
#define XB_XGEN(j)  (2304 + 64 * (j))
#define XB_TOP      3328
#define XB_TOPGEN   3392
#define XCD_BAR_WORDS 3456
#define XB_SPIN_CAP (1u << 18)

__device__ __forceinline__ unsigned xb_ld(unsigned* p)              { return __hip_atomic_load(p, __ATOMIC_RELAXED, __HIP_MEMORY_SCOPE_AGENT); }
__device__ __forceinline__ unsigned xb_add(unsigned* p, unsigned v) { return __hip_atomic_fetch_add(p, v, __ATOMIC_RELAXED, __HIP_MEMORY_SCOPE_AGENT); }
__device__ __forceinline__ unsigned xb_xcc_id() { return (unsigned)__builtin_amdgcn_s_getreg((3 << 11) | 20) & 0xFu; }
#define XB_SPIN(cond, bar) do { unsigned _sp = 0; while (cond) { __builtin_amdgcn_s_sleep(1); \
    if ((++_sp & 255u) == 0u) { if (xb_ld(&(bar)[XB_TMO])) break; if (_sp > XB_SPIN_CAP) { atomicAdd(&(bar)[XB_TMO], 1u); break; } } } } while (0)

struct XcdBarrier {
    unsigned* bar; unsigned x;
    volatile LAS unsigned* st;
};

__device__ __forceinline__ XcdBarrier xcd_barrier_post(unsigned* bar, volatile LAS unsigned* st) {
    XcdBarrier b; b.bar = bar; b.x = xb_xcc_id(); b.st = st;
    if (threadIdx.x == 0) (void)xb_add(&bar[XB_XCNT(b.x)], 1u);
    return b;
}
__device__ __forceinline__ void xcd_barrier_complete(unsigned* bar, unsigned x, unsigned& nloc, unsigned& nx) {
    const unsigned G = gridDim.x * gridDim.y * gridDim.z;
    unsigned sum, cnt, mine, sp = 0u;
    for (;;) {
        sum = 0u; cnt = 0u; mine = 0u;
#pragma unroll
        for (unsigned j = 0; j < 16; ++j) { const unsigned c = xb_ld(&bar[XB_XCNT(j)]); sum += c; cnt += (c > 0u) ? 1u : 0u; mine = (j == x) ? c : mine; }
        if (sum == G) break;
        __builtin_amdgcn_s_sleep(1);
        if ((++sp & 255u) == 0u) { if (xb_ld(&bar[XB_TMO])) break; if (sp > XB_SPIN_CAP) { atomicAdd(&bar[XB_TMO], 1u); break; } }
    }
    nloc = mine > 0u ? mine : 1u; nx = cnt > 0u ? cnt : 1u;
}

__device__ __forceinline__ void xcd_barrier(const XcdBarrier& b) {
    asm volatile("s_waitcnt vmcnt(0)" ::: "memory");
    __syncthreads();
    if (threadIdx.x == 0) {
        unsigned* bar = b.bar;
        __builtin_amdgcn_s_waitcnt(0);
        unsigned nloc = b.st[0], nx = b.st[1];
        if (nloc == 0u) { xcd_barrier_complete(bar, b.x, nloc, nx); b.st[0] = nloc; b.st[1] = nx; }
        const unsigned old = xb_add(&bar[XB_XSUB(b.x)], 1u);
        const unsigned gen = old / nloc;
        if (old + 1u == (gen + 1u) * nloc) {
            __builtin_amdgcn_fence(__ATOMIC_RELEASE, "agent");
            asm volatile("s_waitcnt vmcnt(0)" ::: "memory");
            const unsigned og = xb_add(&bar[XB_TOP], 1u);
            const unsigned tg = og / nx;
            if (og + 1u == (tg + 1u) * nx) xb_add(&bar[XB_TOPGEN], 1u);
            else XB_SPIN(xb_ld(&bar[XB_TOPGEN]) == tg, bar);
            __builtin_amdgcn_fence(__ATOMIC_ACQUIRE, "agent");
            xb_add(&bar[XB_XGEN(b.x)], 1u);
            asm volatile("s_waitcnt vmcnt(0)" ::: "memory");
        } else {
            XB_SPIN(xb_ld(&bar[XB_XGEN(b.x)]) == gen, bar);
            __builtin_amdgcn_fence(__ATOMIC_ACQUIRE, "agent");
            asm volatile("s_waitcnt vmcnt(0)" ::: "memory");
        }
    }
    __syncthreads();
}

__device__ __forceinline__ void xcd_local_barrier(unsigned* cnt, unsigned target) {
    asm volatile("s_waitcnt vmcnt(0)" ::: "memory");
    __syncthreads();
    if (threadIdx.x == 0) {
        __builtin_amdgcn_s_waitcnt(0);
        (void)__hip_atomic_fetch_add(cnt, 1u, __ATOMIC_RELAXED, __HIP_MEMORY_SCOPE_AGENT);
        unsigned sp = 0;
        while (xb_ld(cnt) < target) { __builtin_amdgcn_s_sleep(1); if (++sp > XB_SPIN_CAP) break; }
        __builtin_amdgcn_fence(__ATOMIC_ACQUIRE, "agent");
        asm volatile("s_waitcnt vmcnt(0)" ::: "memory");
    }
    __syncthreads();
}

struct Args {
    const float* x; const int* pos; const float* g_pre1; const float* w1g; const float* w1u; const float* w1d; const float* g_post1; const float* g_mpre; const float* w_in; const float* relb;
    const float* sinks; const float* w_out; const float* g_mpost; const float* g_pre2; const float* w2g; const float* w2u; const float* w2d; const float* g_post2; const float* g_fin;
    float* out; unsigned char* ws; float invf[8]; int ph_lo, ph_hi;
};
__device__ __forceinline__ void rms_row_to_bf16(const float* xrow, const float* g, bf16* orow, int lane) {
    const f32x4* xr = (const f32x4*)xrow + lane; const f32x4* gr = (const f32x4*)g + lane;
    f32x4 v[4]; float s = 0.f;
#pragma unroll
    for (int j = 0; j < 4; ++j) { v[j] = xr[64 * j]; s += (v[j].x * v[j].x + v[j].y * v[j].y) + (v[j].z * v[j].z + v[j].w * v[j].w); }
    const float r = 1.0f / sqrtf(wave_sum(s) * (1.f / D) + EPS);
    v2u* o8 = (v2u*)orow + lane;
#pragma unroll
    for (int j = 0; j < 4; ++j) { const f32x4 gg = gr[64 * j]; v2u w; w.x = pk2(v[j].x * r * gg.x, v[j].y * r * gg.y); w.y = pk2(v[j].z * r * gg.z, v[j].w * r * gg.w); o8[64 * j] = w; }
}
__device__ __forceinline__ f32x4 ld_bf4(const bf16* p) { const v2u w = *(const v2u*)p; f32x4 r; r.x = __uint_as_float(w.x << 16); r.y = __uint_as_float(w.x & 0xffff0000u); r.z = __uint_as_float(w.y << 16); r.w = __uint_as_float(w.y & 0xffff0000u); return r; }
__device__ __forceinline__ void st_bf4(bf16* p, f32x4 v) { v2u w; w.x = pk2(v.x, v.y); w.y = pk2(v.z, v.w); *(v2u*)p = w; }
template <bool BF32, int R> struct RowBuf { f32x4 bf[BF32 ? R : 1][4]; v2u bh[BF32 ? 1 : R][4]; v2u f[R][4]; float ss[R], rp[R]; };
template <bool BF32, int R>
__device__ __forceinline__ void fix_load(RowBuf<BF32, R>& B, int row0, const float* basef, const bf16* F, const float* rpart, const float* rowr, const bf16* xn, int lane) {
#pragma unroll
    for (int r = 0; r < R; ++r) { const size_t ro = (size_t)(row0 + r) * D + 4 * lane;
        B.ss[r] = lane < 16 ? rpart[(size_t)(row0 + r) * 16 + lane] : 0.f; B.rp[r] = BF32 ? 1.f : rowr[row0 + r];
#pragma unroll
        for (int j = 0; j < 4; ++j) { if (BF32) B.bf[r][j] = *(const f32x4*)(basef + ro + 256 * j); else B.bh[r][j] = *(const v2u*)(xn + ro + 256 * j); B.f[r][j] = *(const v2u*)(F + ro + 256 * j); } }
}
__device__ __forceinline__ f32x4 cv_bf4(v2u w) { f32x4 r; r.x = __uint_as_float(w.x << 16); r.y = __uint_as_float(w.x & 0xffff0000u); r.z = __uint_as_float(w.y << 16); r.w = __uint_as_float(w.y & 0xffff0000u); return r; }
template <int MODE, bool BF32, int R>
__device__ __forceinline__ void fix_compute(RowBuf<BF32, R>& B, int row0, float coef, const f32x4 (&gp)[4], const f32x4 (&gi)[4], const f32x4 (&gn)[4], float* rowr, bf16* xn, float* outf, int lane) {
#pragma unroll
    for (int r = 0; r < R; ++r) { const size_t ro = (size_t)(row0 + r) * D + 4 * lane;
        const float rf = coef / sqrtf(wave_sum(B.ss[r]) * (1.f / D) + EPS), rpi = BF32 ? 1.f : 1.0f / B.rp[r]; float s = 0.f; f32x4 h[4];
#pragma unroll
        for (int j = 0; j < 4; ++j) { const f32x4 bs = BF32 ? B.bf[r][j] : (cv_bf4(B.bh[r][j]) * rpi) * gi[j]; h[j] = bs + (cv_bf4(B.f[r][j]) * rf) * gp[j]; s += (h[j].x * h[j].x + h[j].y * h[j].y) + (h[j].z * h[j].z + h[j].w * h[j].w); }
        const float rh = 1.0f / sqrtf(wave_sum(s) * (1.f / D) + EPS);
        if (MODE == 0 && lane == 0) rowr[row0 + r] = rh;
#pragma unroll
        for (int j = 0; j < 4; ++j) { const f32x4 o = (h[j] * rh) * gn[j];
            if (MODE == 0) { st_bf4(xn + ro + 256 * j, o); } else { *(f32x4*)(outf + ro + 256 * j) = o; } } }
}
template <int MODE, bool BF32>
__device__ __forceinline__ void fix_phase(int gw, int NGW, int rb, int re, const float* basef, const bf16* F, const float* rpart, float coef, const float* gpost, const float* gprev, const float* gnext, float* rowr, bf16* xn, float* outf, int lane) {
    constexpr int R = 2;
    f32x4 gp[4], gi[4], gn[4];
#pragma unroll
    for (int j = 0; j < 4; ++j) { gp[j] = *(const f32x4*)(gpost + 4 * lane + 256 * j); gn[j] = *(const f32x4*)(gnext + 4 * lane + 256 * j);
        if (!BF32) { const f32x4 gv = *(const f32x4*)(gprev + 4 * lane + 256 * j); gi[j] = (f32x4){1.0f / gv.x, 1.0f / gv.y, 1.0f / gv.z, 1.0f / gv.w}; } else gi[j] = (f32x4){1.f, 1.f, 1.f, 1.f}; }
    const int step = NGW * R; int m = rb + gw * R;
    RowBuf<BF32, R> A, B;
    if (m < re) fix_load<BF32, R>(A, m, basef, F, rpart, rowr, xn, lane);
    for (; m < re; m += 2 * step) {
        if (m + step < re) fix_load<BF32, R>(B, m + step, basef, F, rpart, rowr, xn, lane);
        fix_compute<MODE, BF32, R>(A, m, coef, gp, gi, gn, rowr, xn, outf, lane);
        if (m + step < re) { if (m + 2 * step < re) fix_load<BF32, R>(A, m + 2 * step, basef, F, rpart, rowr, xn, lane);
            fix_compute<MODE, BF32, R>(B, m + step, coef, gp, gi, gn, rowr, xn, outf, lane); }
    }
}
__device__ __forceinline__ void p0_rows(int gw, int NGW, const float* x, const float* g, bf16* XN, int lane) {
    f32x4 gg[4];
#pragma unroll
    for (int j = 0; j < 4; ++j) gg[j] = *(const f32x4*)(g + 4 * lane + 256 * j);
    constexpr int R = 2; const int step = NGW * R; int m = gw * R;
    f32x4 A[R][4], B[R][4];
#define P0_LOAD(buf, mm) do { _Pragma("unroll") for (int r = 0; r < R; ++r) _Pragma("unroll") for (int j = 0; j < 4; ++j) buf[r][j] = *(const f32x4*)(x + (size_t)((mm) + r) * D + 4 * lane + 256 * j); } while (0)
#define P0_DO(buf, mm) do { _Pragma("unroll") for (int r = 0; r < R; ++r) { float s = 0.f; \
        _Pragma("unroll") for (int j = 0; j < 4; ++j) s += (buf[r][j].x * buf[r][j].x + buf[r][j].y * buf[r][j].y) + (buf[r][j].z * buf[r][j].z + buf[r][j].w * buf[r][j].w); \
        const float rr = 1.0f / sqrtf(wave_sum(s) * (1.f / D) + EPS); \
        _Pragma("unroll") for (int j = 0; j < 4; ++j) st_bf4(XN + (size_t)((mm) + r) * D + 4 * lane + 256 * j, (buf[r][j] * rr) * gg[j]); } } while (0)
    if (m < M) P0_LOAD(A, m);
    for (; m < M; m += 2 * step) {
        if (m + step < M) P0_LOAD(B, m + step);
        P0_DO(A, m);
        if (m + step < M) { if (m + 2 * step < M) P0_LOAD(A, m + 2 * step); P0_DO(B, m + step); }
    }
#undef P0_LOAD
#undef P0_DO
}

__global__ void __launch_bounds__(NWAVES * 64, 2) mk_fwd(Args a) {
    __builtin_assume(__builtin_amdgcn_workitem_id_y() == 0); __builtin_assume(__builtin_amdgcn_workitem_id_z() == 0);
    extern __shared__ __attribute__((aligned(16))) unsigned char lds_raw[];
    LAS unsigned char* lds = (LAS unsigned char*)lds_raw;
    const int tid = threadIdx.x, lane = tid & 63, wave = __builtin_amdgcn_readfirstlane(tid >> 6);
    const int G = gridDim.x, bx = blockIdx.x;
    int vcu = (G % 8 == 0) ? (bx % 8) * (G / 8) + bx / 8 : bx;
    int gw = vcu * NWAVES + wave; const int NGW = G * NWAVES;
    int cbx = bx, xloc = 0, xidx = 0, xrank = 0;
    unsigned lep = 0;
    unsigned char* ws = a.ws;
    bf16* W1GU = (bf16*)(ws + WS_W1GU); bf16* W1D = (bf16*)(ws + WS_W1D); bf16* WIN = (bf16*)(ws + WS_WIN); bf16* WOUT = (bf16*)(ws + WS_WOUT); bf16* W2GU = (bf16*)(ws + WS_W2GU); bf16* W2D = (bf16*)(ws + WS_W2D);
    float* ROPE = (float*)(ws + WS_ROPE); float* RPART = (float*)(ws + WS_RPART);
    bf16* XN = (bf16*)(ws + WS_XN); bf16* ACT = (bf16*)(ws + WS_ACT); bf16* QKV = (bf16*)(ws + WS_ACT);     bf16* OB = (bf16*)(ws + WS_H); bf16* FB = (bf16*)(ws + WS_F);
    float* ROWR = (float*)(ws + WS_ROWR);
    const int lo = a.ph_lo, hi = a.ph_hi;
    volatile LAS unsigned* MISC = (volatile LAS unsigned*)(lds + LDS_BYTES - 64);
    if (tid < 16) MISC[tid] = 0u;
    __syncthreads();
    XcdBarrier bar = xcd_barrier_post((unsigned*)(ws + WS_CTL) + CW_BAR, MISC + 8);
    if (tid == 0) { const unsigned xcc = xb_xcc_id(); MISC[0] = xcc; MISC[1] = xb_add((unsigned*)(ws + WS_CTL) + CW_XCNT + 64 * xcc, 1u); }
#define IN(k) (lo <= (k) && (k) < hi)
    if (hi > 1000) cg::this_grid().sync();
#define SEAM(k) do { if (IN(k) && IN((k) + 1)) { xcd_barrier(bar); } } while (0)
#define LSEAM(k) do { if (IN(k) && IN((k) + 1)) { if (xloc) { ++lep; xcd_local_barrier((unsigned*)(ws + WS_CTL) + CW_XLB + 64 * xidx, lep * (unsigned)(G / 8)); } else xcd_barrier(bar); } } while (0)

    if (IN(0)) {
        LAS float* scr = (LAS float*)(lds + wave * 16384);
        constexpr int I_GU = (D / 64) * (FF / 32), I_DN = (FF / 64) * (D / 32), I_IN = (D / 64) * (DIN / 32), I_OUT = (D / 64) * (D / 32);
        constexpr int NITEMS = 4 * I_GU + 2 * I_DN + I_IN + I_OUT;
        for (int it = gw; it < NITEMS; it += NGW) {
            int r = it;
            if (r < I_GU) { p0_transpose_item(a.w1g, D, FF, W1GU, 1, scr, r, lane); continue; } r -= I_GU;
            if (r < I_GU) { p0_transpose_item(a.w1u, D, FF, W1GU, 2, scr, r, lane); continue; } r -= I_GU;
            if (r < I_GU) { p0_transpose_item(a.w2g, D, FF, W2GU, 1, scr, r, lane); continue; } r -= I_GU;
            if (r < I_GU) { p0_transpose_item(a.w2u, D, FF, W2GU, 2, scr, r, lane); continue; } r -= I_GU;
            if (r < I_DN) { p0_transpose_item(a.w1d, FF, D, W1D, 0, scr, r, lane); continue; } r -= I_DN;
            if (r < I_DN) { p0_transpose_item(a.w2d, FF, D, W2D, 0, scr, r, lane); continue; } r -= I_DN;
            if (r < I_IN) { p0_transpose_item(a.w_in, D, DIN, WIN, 0, scr, r, lane); continue; } r -= I_IN;
            p0_transpose_item(a.w_out, D, D, WOUT, 0, scr, r, lane);
        }
        for (int i = gw * 64 + lane; i < M * 8; i += NGW * 64) { const int tok = i >> 3, j = i & 7;
            const float ang = (float)a.pos[tok] * a.invf[j];
            const double rev = (double)ang * 0.15915494309189535; const float fr = (float)(rev - floor(rev));
            ROPE[(size_t)tok * 16 + j] = __builtin_amdgcn_cosf(fr); ROPE[(size_t)tok * 16 + 8 + j] = __builtin_amdgcn_sinf(fr); }
        p0_rows(gw, NGW, a.x, a.g_pre1, XN, lane);
    }
    SEAM(0);
    if (IN(0) && IN(1)) {
        if (tid == 0) { const unsigned xcc = MISC[0]; unsigned npop = 0, before = 0, ok = (G % 8 == 0) ? 1u : 0u;
            for (unsigned j = 0; j < 16; ++j) { const unsigned cj = xb_ld((unsigned*)(ws + WS_CTL) + CW_XCNT + 64 * j); if (cj) { ++npop; if (cj != (unsigned)(G / 8)) ok = 0u; if (j < xcc) ++before; } }
            if (npop != 8u) ok = 0u;
            MISC[2] = ok; MISC[3] = before; }
        __syncthreads();
        xloc = __builtin_amdgcn_readfirstlane((int)MISC[2]); xidx = __builtin_amdgcn_readfirstlane((int)MISC[3]); xrank = __builtin_amdgcn_readfirstlane((int)MISC[1]);
        if (xloc) { vcu = xidx * (G / 8) + xrank; cbx = xrank * 8 + xidx; gw = vcu * NWAVES + wave; }
    }
    if (xloc) QKV = (bf16*)(ws + WS_ACT + (size_t)xidx * ((size_t)(M / 8) * (2 * FF - 2 * DIN)));
    const int rb = xloc ? xidx * (M / 8) : 0, re = xloc ? (xidx + 1) * (M / 8) : M, rgw = xloc ? xrank * NWAVES + wave : gw, RNGW = xloc ? (G / 8) * NWAVES : NGW;
    if (IN(1)) { pg8::Gemm g{XN, W1GU, M, 2 * FF, D}; pg8::StaticOrder S; S.init(M, 2 * FF, G, cbx); pg8::EpiSwiglu E{ACT, FF};
        pg8::gemm_phase<pg8::EpiSwiglu, pg8::StaticOrder, true, true>(lds, g, S, E); }
    LSEAM(1);
    if (IN(2)) { pg8::Gemm g{ACT, W1D, M, D, FF}; pg8::StaticOrder S; S.init(M, D, G, cbx); pg8::EpiRawSS E{FB, D, RPART};
        pg8::gemm_phase<pg8::EpiRawSS, pg8::StaticOrder, true, true>(lds, g, S, E); }
    LSEAM(2);
    if (IN(3)) fix_phase<0, true>(rgw, RNGW, rb, re, a.x, FB, RPART, 0.5f, a.g_post1, nullptr, a.g_mpre, ROWR, XN, nullptr, lane);
    LSEAM(3);
    if (IN(4)) { pg8::Gemm g{XN, WIN, M, DIN, D}; pg8::StaticOrder S; S.init(M, DIN, G, cbx); pg8::EpiQKV E{QKV, DIN, 0.125f * 1.4426950408889634f};
        pg8::gemm_phase<pg8::EpiQKV, pg8::StaticOrder, true, true>(lds, g, S, E); }
    LSEAM(4);
    if (IN(5)) {
        for (int i = rb * 10 + (rgw * 64 + lane); i < re * 10; i += RNGW * 64) { const int tok = i / 10, hh = i - tok * 10;
            bf16* p = QKV + (size_t)tok * DIN + (hh < 8 ? 1536 + 64 * hh : 2048 + 64 * (hh - 8));
            const v4u a0 = *(const v4u*)p, a1 = *(const v4u*)(p + 8); const f32x4* rp = (const f32x4*)(ROPE + (size_t)tok * 16); const f32x4 c0 = rp[0], c1 = rp[1], s0 = rp[2], s1 = rp[3];
            float x1[8], x2[8];
#pragma unroll
            for (int k = 0; k < 4; ++k) { x1[2 * k] = __uint_as_float(a0[k] << 16); x1[2 * k + 1] = __uint_as_float(a0[k] & 0xffff0000u); x2[2 * k] = __uint_as_float(a1[k] << 16); x2[2 * k + 1] = __uint_as_float(a1[k] & 0xffff0000u); }
            const float cs[8] = {c0.x, c0.y, c0.z, c0.w, c1.x, c1.y, c1.z, c1.w}, sn[8] = {s0.x, s0.y, s0.z, s0.w, s1.x, s1.y, s1.z, s1.w};
            v4u o0, o1;
#pragma unroll
            for (int k = 0; k < 4; ++k) { o0[k] = pk2(x1[2 * k] * cs[2 * k] - x2[2 * k] * sn[2 * k], x1[2 * k + 1] * cs[2 * k + 1] - x2[2 * k + 1] * sn[2 * k + 1]);
                o1[k] = pk2(x2[2 * k] * cs[2 * k] + x1[2 * k] * sn[2 * k], x2[2 * k + 1] * cs[2 * k + 1] + x1[2 * k + 1] * sn[2 * k + 1]); }
            *(v4u*)p = o0; *(v4u*)(p + 8) = o1; }
        if (xloc) { ++lep; xcd_local_barrier((unsigned*)(ws + WS_CTL) + CW_XLB + 64 * xidx, lep * (unsigned)(G / 8)); } else xcd_barrier(bar);
        LAS float* bt = (LAS float*)(lds + att::LDS_BT);
        for (int i = tid; i < 8 * 320; i += NWAVES * 64) { const int hh = i / 320, k = i % 320; bt[hh * att::BT_STRIDE + k] = a.relb[hh * 257 + (k < 256 ? k : 256)] * 1.4426950408889634f; }
        __syncthreads();
        for (int u = vcu; u < BATCH * 32; u += G) {
            const int c = ((u & 7) + 8 * (u >> 8)) & 31, b = (u >> 3) & 31;
            att::attn_round<0>(QKV, OB, b, c, 0, lds, a.sinks, tid);
            att::attn_round<0>(QKV, OB, b, c, 1, lds, a.sinks, tid);
            att::attn_round<1>(QKV, OB, b, c, 0, lds, a.sinks, tid);
            att::attn_round<1>(QKV, OB, b, c, 1, lds, a.sinks, tid);
        }
        __syncthreads();
    }
    LSEAM(5);
    if (IN(6)) { pg8::Gemm g{OB, WOUT, M, D, D}; pg8::StaticOrder S; S.init(M, D, G, cbx); pg8::EpiRawSS E{FB, D, RPART};
        pg8::gemm_phase<pg8::EpiRawSS, pg8::StaticOrder, true, true>(lds, g, S, E); }
    LSEAM(6);
    if (IN(7)) fix_phase<0, false>(rgw, RNGW, rb, re, nullptr, FB, RPART, 1.0f, a.g_mpost, a.g_mpre, a.g_pre2, ROWR, XN, nullptr, lane);
    LSEAM(7);
    if (IN(8)) { pg8::Gemm g{XN, W2GU, M, 2 * FF, D}; pg8::StaticOrder S; S.init(M, 2 * FF, G, cbx); pg8::EpiSwiglu E{ACT, FF};
        pg8::gemm_phase<pg8::EpiSwiglu, pg8::StaticOrder, true, true>(lds, g, S, E); }
    LSEAM(8);
    if (IN(9)) { pg8::Gemm g{ACT, W2D, M, D, FF}; pg8::StaticOrder S; S.init(M, D, G, cbx); pg8::EpiRawSS E{FB, D, RPART};
        pg8::gemm_phase<pg8::EpiRawSS, pg8::StaticOrder, true, true>(lds, g, S, E); }
    LSEAM(9);
    if (IN(10)) fix_phase<1, false>(rgw, RNGW, rb, re, nullptr, FB, RPART, 0.5f, a.g_post2, a.g_pre2, a.g_fin, ROWR, XN, a.out, lane);
#undef IN
#undef SEAM
#undef LSEAM
}

extern "C" void kernel_launch(void* const* d_in, const int* in_sizes, int n_in, void* d_out, int out_size, void* d_ws, size_t ws_size, hipStream_t stream) {
    static int grid = 0;
    if (grid == 0) {
        if (n_in != 19 || in_sizes[0] != M * D || out_size != M * D || ws_size < WS_END) { fprintf(stderr, "kernel_launch: unexpected shapes (n_in %d, in0 %d, out %d, ws %zu)\n", n_in, n_in > 0 ? in_sizes[0] : -1, out_size, ws_size); grid = -1; return; }
        int dev = 0, cus = 0, per_cu = 0;
        if (hipGetDevice(&dev) != hipSuccess || hipDeviceGetAttribute(&cus, hipDeviceAttributeMultiprocessorCount, dev) != hipSuccess) { grid = -1; return; }
        if (hipFuncSetAttribute((const void*)mk_fwd, hipFuncAttributeMaxDynamicSharedMemorySize, LDS_BYTES) != hipSuccess) { fprintf(stderr, "kernel_launch: hipFuncSetAttribute failed\n"); grid = -1; return; }
        if (hipOccupancyMaxActiveBlocksPerMultiprocessor(&per_cu, (const void*)mk_fwd, NWAVES * 64, LDS_BYTES) != hipSuccess || per_cu < 1) { fprintf(stderr, "kernel_launch: occupancy query says %d\n", per_cu); per_cu = 1; }
        (void)hipGetLastError();
        grid = cus * 1;
    }
    if (grid < 0) return;
    if (hipMemsetAsync((char*)d_ws + WS_CTL, 0, CTL_ZERO_BYTES, stream) != hipSuccess) { fprintf(stderr, "kernel_launch: memset failed\n"); return; }
    Args a{};
    a.x = (const float*)d_in[0]; a.pos = (const int*)d_in[1]; a.g_pre1 = (const float*)d_in[2]; a.w1g = (const float*)d_in[3]; a.w1u = (const float*)d_in[4]; a.w1d = (const float*)d_in[5];
    a.g_post1 = (const float*)d_in[6]; a.g_mpre = (const float*)d_in[7]; a.w_in = (const float*)d_in[8]; a.relb = (const float*)d_in[9]; a.sinks = (const float*)d_in[10]; a.w_out = (const float*)d_in[11];
    a.g_mpost = (const float*)d_in[12]; a.g_pre2 = (const float*)d_in[13]; a.w2g = (const float*)d_in[14]; a.w2u = (const float*)d_in[15]; a.w2d = (const float*)d_in[16]; a.g_post2 = (const float*)d_in[17]; a.g_fin = (const float*)d_in[18];
    a.out = (float*)d_out; a.ws = (unsigned char*)d_ws;
    for (int j = 0; j < 8; ++j) a.invf[j] = (float)std::pow(500000.0, -(double)j / 8.0);
#if MK_PER_PHASE
    for (int p = 0; p < NPHASE; ++p) { a.ph_lo = p; a.ph_hi = p + 1; hipLaunchKernelGGL(mk_fwd, dim3(grid), dim3(NWAVES * 64), LDS_BYTES, stream, a); }
#else
    a.ph_lo = 0; a.ph_hi = NPHASE;
    void* args[] = {&a};
    hipError_t e = hipLaunchCooperativeKernel((const void*)mk_fwd, dim3(grid), dim3(NWAVES * 64), args, LDS_BYTES, stream);
    if (e != hipSuccess) fprintf(stderr, "cooperative launch failed: %s (grid %d)\n", hipGetErrorString(e), grid);
#endif
}
```
